# Optimizing an MI355X kernel written in HIP

```python
import jax, jax.numpy as jnp
from jax import lax
import numpy as np

D_MODEL = 2048
BATCH = 8
SEQ = 2048
DEPTH = 4

BLOCK_Q = 128
HEAD_DIM = 128
ROPE_THETA = 10000.0
EPS = 1e-6
N_BRANCH = 4
BRANCH_WIDTH = 512
SB_HEADS = 4
SB_W = SB_HEADS * HEAD_DIM
MLA_HEADS = 4
MLA_NOPE = 128
MLA_ROPE = 64
MLA_V = 128
MLA_KV_RANK = 512
MLA_Q_W = MLA_HEADS * (MLA_NOPE + MLA_ROPE)
RET_HEADS = 4
RET_DK = 128
RET_DV = 128
RET_CHUNK = 128
RET_W = RET_HEADS * RET_DK
RET_VW = RET_HEADS * RET_DV
LRU_WIDTH = 512
LRU_BLOCKS = 4
LRU_BLOCK = LRU_WIDTH // LRU_BLOCKS
CONV_WIDTH = 4
LRU_C = 8.0
D_FF = -(-8 * D_MODEL // (3 * 256)) * 256
SPLIT_SIZES = (SB_W, SB_W, SB_W,
               MLA_Q_W, MLA_KV_RANK, MLA_ROPE,
               RET_W, RET_W, RET_VW, RET_VW,
               LRU_WIDTH, LRU_WIDTH)
IN_WIDTH = sum(SPLIT_SIZES)

kernel_name = "hybrid_gated_sb_mla_ret_rglru_block"


def rmsnorm(x, g):
    xf = x.astype(jnp.float32)
    y = xf * lax.rsqrt(jnp.mean(xf * xf, axis=-1, keepdims=True) + EPS)
    return (y * g.astype(jnp.float32)).astype(x.dtype)


def rope(x, pos):
    d = x.shape[-1]
    freq = ROPE_THETA ** (-jnp.arange(0, d, 2, dtype=jnp.float32) / d)
    ang = pos.astype(jnp.float32)[:, :, None] * freq
    cos = jnp.cos(ang)[:, :, None, :]
    sin = jnp.sin(ang)[:, :, None, :]
    xf = x.astype(jnp.float32)
    x1, x2 = xf[..., : d // 2], xf[..., d // 2:]
    return jnp.concatenate([x1 * cos - x2 * sin, x2 * cos + x1 * sin], axis=-1).astype(x.dtype)


def stick_breaking_attention(q, k, v):
    S, D = q.shape[1], q.shape[-1]
    scale = D ** -0.5
    outs = []
    for i0 in range(0, S, BLOCK_Q):
        L = i0 + BLOCK_Q
        z = jnp.einsum('bqhd,bkhd->bhqk', q[:, i0:L], k[:, :L]).astype(jnp.float32) * scale
        t_idx = i0 + jnp.arange(BLOCK_Q)[:, None]
        s_idx = jnp.arange(L)[None, :]
        mask = s_idx < t_idx
        log_1m_beta = jnp.where(mask, jax.nn.log_sigmoid(-z), 0.0)
        tail = lax.cumsum(log_1m_beta, axis=3, reverse=True) - log_1m_beta
        w = jnp.where(mask, jnp.exp(jax.nn.log_sigmoid(z) + tail), 0.0)
        outs.append(jnp.einsum('bhqk,bkhd->bqhd', w.astype(v.dtype), v[:, :L]))
    return jnp.concatenate(outs, axis=1)


def latent_attention(q, c_kv, k_rope, pos, kv_gain, w_ukv):
    B, S = q.shape[0], q.shape[1]
    q_nope = q[..., :MLA_NOPE]
    q_pe = rope(q[..., MLA_NOPE:], pos)
    k_pe = rope(k_rope[:, :, None, :], pos)[:, :, 0, :]
    kv = (rmsnorm(c_kv, kv_gain) @ w_ukv).reshape(B, S, MLA_HEADS, MLA_NOPE + MLA_V)
    k_nope, v = kv[..., :MLA_NOPE], kv[..., MLA_NOPE:]
    scale = (MLA_NOPE + MLA_ROPE) ** -0.5
    outs = []
    for i0 in range(0, S, BLOCK_Q):
        L = i0 + BLOCK_Q
        s = (jnp.einsum('bqhd,bkhd->bhqk', q_nope[:, i0:L], k_nope[:, :L])
             + jnp.einsum('bqhd,bkd->bhqk', q_pe[:, i0:L], k_pe[:, :L])).astype(jnp.float32) * scale
        mask = jnp.arange(L)[None, :] <= (i0 + jnp.arange(BLOCK_Q))[:, None]
        p = jax.nn.softmax(jnp.where(mask, s, -jnp.inf), axis=-1)
        outs.append(jnp.einsum('bhqk,bkhd->bqhd', p.astype(v.dtype), v[:, :L]))
    return jnp.concatenate(outs, axis=1).reshape(B, S, MLA_HEADS * MLA_V)


def retention(q, k, v, g, pos):
    B, S, H, DK = q.shape
    DV = v.shape[-1]
    C = RET_CHUNK
    N = S // C
    q = rope(q, pos).astype(jnp.float32)
    k = rope(k, pos).astype(jnp.float32) * DK ** -0.5
    log_gamma = jnp.log1p(-(2.0 ** (-5.0 - jnp.arange(H, dtype=jnp.float32))))
    qc = q.reshape(B, N, C, H, DK)
    kc = k.reshape(B, N, C, H, DK)
    vc = v.astype(jnp.float32).reshape(B, N, C, H, DV)
    idx = jnp.arange(C, dtype=jnp.float32)
    diff = idx[:, None] - idx[None, :]
    decay = jnp.where(diff >= 0, jnp.exp(log_gamma[:, None, None] * jnp.maximum(diff, 0.0)), 0.0)
    scores = jnp.einsum('bnqhd,bnkhd->bnhqk', qc, kc) * decay
    inner = jnp.einsum('bnhqk,bnkhe->bnqhe', scores, vc)
    k_decay = jnp.exp(log_gamma[:, None] * (C - 1.0 - idx)[None, :])
    chunk_kv = jnp.einsum('bnkhd,hk,bnkhe->bnhde', kc, k_decay, vc)
    chunk_decay = jnp.exp(log_gamma * C)[None, :, None, None]

    def step(state, kv_i):
        return state * chunk_decay + kv_i, state

    init = jnp.zeros((B, H, DK, DV), jnp.float32)
    _, prev = lax.scan(step, init, jnp.moveaxis(chunk_kv, 1, 0))
    prev = jnp.moveaxis(prev, 0, 1)
    q_decay = jnp.exp(log_gamma[:, None] * (idx + 1.0)[None, :])
    cross = jnp.einsum('bnqhd,hq,bnhde->bnqhe', qc, q_decay, prev)
    o = (inner + cross).reshape(B, S, H, DV)
    o = o * lax.rsqrt(jnp.mean(o * o, axis=-1, keepdims=True) + EPS)
    o = o.reshape(B, S, H * DV) * jax.nn.silu(g.astype(jnp.float32))
    return o.astype(v.dtype)


def rglru_block(x_in, y_in, conv_w, conv_b, w_a, b_a, w_x, b_x, lam):
    B, S, W = x_in.shape
    xf = x_in.astype(jnp.float32)
    xp = jnp.pad(xf, ((0, 0), (CONV_WIDTH - 1, 0), (0, 0)))
    xc = conv_b.astype(jnp.float32) + xp[:, 0:S] * conv_w[0]
    for tap in range(1, CONV_WIDTH):
        xc = xc + xp[:, tap:tap + S] * conv_w[tap]
    xb = xc.reshape(B, S, LRU_BLOCKS, LRU_BLOCK)
    r = jax.nn.sigmoid(jnp.einsum('bshi,hij->bshj', xb, w_a.astype(jnp.float32)).reshape(B, S, W) + b_a)
    i = jax.nn.sigmoid(jnp.einsum('bshi,hij->bshj', xb, w_x.astype(jnp.float32)).reshape(B, S, W) + b_x)
    log_a = -LRU_C * r * jax.nn.softplus(-lam.astype(jnp.float32))
    a = jnp.exp(log_a)
    b = jnp.sqrt(-jnp.expm1(2.0 * log_a)) * (i * xc)

    def combine(left, right):
        a1, b1 = left
        a2, b2 = right
        return a1 * a2, a2 * b1 + b2

    _, h = lax.associative_scan(combine, (a, b), axis=1)
    return (h * jax.nn.gelu(y_in.astype(jnp.float32))).astype(x_in.dtype)


def hybrid_layer(x, positions, ln1, w_in, kv_gain, w_ukv, conv_w, conv_b, w_a, b_a, w_x, b_x, lam,
                 w_branch, w_gate, w_out, ln2, wf_gate, wf_up, wf_down):
    B, S, _ = x.shape
    h = rmsnorm(x, ln1)
    proj = h @ w_in
    bounds = np.cumsum(SPLIT_SIZES)[:-1].tolist()
    (sb_q, sb_k, sb_v, mla_q, mla_ckv, mla_kr,
     ret_q, ret_k, ret_v, ret_g, lru_x, lru_y) = jnp.split(proj, bounds, axis=-1)

    def heads(t, n):
        return t.reshape(B, S, n, -1)

    o_sb = stick_breaking_attention(heads(sb_q, SB_HEADS), heads(sb_k, SB_HEADS),
                                    heads(sb_v, SB_HEADS)).reshape(B, S, SB_W)
    o_mla = latent_attention(heads(mla_q, MLA_HEADS), mla_ckv, mla_kr, positions, kv_gain, w_ukv)
    o_ret = retention(heads(ret_q, RET_HEADS), heads(ret_k, RET_HEADS), heads(ret_v, RET_HEADS),
                      ret_g, positions)
    o_lru = rglru_block(lru_x, lru_y, conv_w, conv_b, w_a, b_a, w_x, b_x, lam)
    branches = (o_sb, o_mla, o_ret, o_lru)

    mixed = jax.nn.sigmoid((h @ w_gate[0]).astype(jnp.float32)) * (branches[0] @ w_branch[0])
    for br in range(1, N_BRANCH):
        gate = jax.nn.sigmoid((h @ w_gate[br]).astype(jnp.float32))
        mixed = mixed + gate * (branches[br] @ w_branch[br])
    x = x + mixed.astype(x.dtype) @ w_out

    h2 = rmsnorm(x, ln2)
    x = x + (jax.nn.silu(h2 @ wf_gate) * (h2 @ wf_up)) @ wf_down
    return x


def setup_inputs(seed: int = 0) -> dict:
    key = jax.random.key(seed)
    ks = jax.random.split(key, 24)
    f32 = jnp.float32
    D = D_MODEL

    def nrm(k, shape, fan_in):
        return jax.random.normal(k, shape, f32) * fan_in ** -0.5

    def gain(k, shape):
        return 1.0 + 0.05 * jax.random.normal(k, shape, f32)

    u = jax.random.uniform(ks[10], (DEPTH, LRU_WIDTH), f32, minval=0.9, maxval=0.999)
    s = u ** (1.0 / LRU_C)
    lam = jnp.log(s) - jnp.log1p(-s)
    return {
        "x": jax.random.normal(ks[0], (BATCH, SEQ, D), f32),
        "positions": jnp.tile(jnp.arange(SEQ, dtype=jnp.int32)[None, :], (BATCH, 1)),
        "ln1": gain(ks[1], (DEPTH, D)),
        "w_in": nrm(ks[2], (DEPTH, D, IN_WIDTH), D),
        "mla_kv_gain": gain(ks[3], (DEPTH, MLA_KV_RANK)),
        "mla_w_ukv": nrm(ks[4], (DEPTH, MLA_KV_RANK, MLA_HEADS * (MLA_NOPE + MLA_V)), MLA_KV_RANK),
        "lru_conv_w": nrm(ks[5], (DEPTH, CONV_WIDTH, LRU_WIDTH), CONV_WIDTH),
        "lru_conv_b": 0.01 * jax.random.normal(ks[6], (DEPTH, LRU_WIDTH), f32),
        "lru_w_a": nrm(ks[7], (DEPTH, LRU_BLOCKS, LRU_BLOCK, LRU_BLOCK), LRU_BLOCK),
        "lru_b_a": 0.01 * jax.random.normal(ks[8], (DEPTH, LRU_WIDTH), f32),
        "lru_w_x": nrm(ks[9], (DEPTH, LRU_BLOCKS, LRU_BLOCK, LRU_BLOCK), LRU_BLOCK),
        "lru_b_x": 0.01 * jax.random.normal(ks[11], (DEPTH, LRU_WIDTH), f32),
        "lru_lambda": lam,
        "w_branch": nrm(ks[12], (DEPTH, N_BRANCH, BRANCH_WIDTH, D), BRANCH_WIDTH),
        "w_gate": nrm(ks[13], (DEPTH, N_BRANCH, D, D), D),
        "w_out": nrm(ks[14], (DEPTH, D, D), D),
        "ln2": gain(ks[15], (DEPTH, D)),
        "ffn_w_gate": nrm(ks[16], (DEPTH, D, D_FF), D),
        "ffn_w_up": nrm(ks[17], (DEPTH, D, D_FF), D),
        "ffn_w_down": nrm(ks[18], (DEPTH, D_FF, D), D_FF),
        "ln_final": gain(ks[19], (D,)),
    }


def reference(x, positions, ln1, w_in, mla_kv_gain, mla_w_ukv, lru_conv_w, lru_conv_b, lru_w_a,
              lru_b_a, lru_w_x, lru_b_x, lru_lambda, w_branch, w_gate, w_out, ln2,
              ffn_w_gate, ffn_w_up, ffn_w_down, ln_final):
    for layer in range(DEPTH):
        x = hybrid_layer(x, positions, ln1[layer], w_in[layer], mla_kv_gain[layer], mla_w_ukv[layer],
                         lru_conv_w[layer], lru_conv_b[layer], lru_w_a[layer], lru_b_a[layer],
                         lru_w_x[layer], lru_b_x[layer], lru_lambda[layer], w_branch[layer],
                         w_gate[layer], w_out[layer], ln2[layer], ffn_w_gate[layer],
                         ffn_w_up[layer], ffn_w_down[layer])
    return rmsnorm(x, ln_final)
```

```cpp
#include <hip/hip_runtime.h>
#include <cstdio>
#include <cstdint>

#ifndef SB_OPT
#define SB_OPT 1
#endif
#ifndef MLA_OPT
#define MLA_OPT 1
#endif
#ifndef REPEAT_PHASE
#define REPEAT_PHASE -1
#endif
#ifndef RET_OPT
#define RET_OPT 1
#endif
#ifndef LRU_OPT
#define LRU_OPT 1
#endif
#ifndef DIAG
#define DIAG 0
#endif
#ifndef DIAG_MODE
#define DIAG_MODE 124
#endif
#ifndef DIAG_UNIFORM
#define DIAG_UNIFORM 0
#endif
#ifndef NOSKIP
#define NOSKIP 0
#endif
#ifndef DIAG_COL
#define DIAG_COL OC_MLA
#endif
#ifndef NAIVE_MIX
#define NAIVE_MIX 0
#endif

#define LAS __attribute__((address_space(3)))
#define GAS __attribute__((address_space(1)))
typedef unsigned short bf16;
typedef short bf16x8 __attribute__((ext_vector_type(8)));
typedef float f32x4 __attribute__((ext_vector_type(4)));
typedef float f32x2 __attribute__((ext_vector_type(2)));
typedef unsigned u32x4 __attribute__((ext_vector_type(4)));
typedef unsigned u32x2 __attribute__((ext_vector_type(2)));
typedef GAS unsigned gu32;

constexpr int DM = 2048, BATCH = 8, SEQ = 2048, DEPTH = 4, M = BATCH * SEQ;
constexpr int NP = 6144;
constexpr int DFF = 5632, INW = 5952;
constexpr float EPS = 1e-6f;
constexpr float LOG2E = 1.4426950408889634f;
constexpr int PC_SBQ = 0, PC_SBK = 512, PC_SBV = 1024, PC_MQN = 1536, PC_MQP = 2048, PC_CKV = 2304, PC_KPE = 2816,
              PC_RQ = 3072, PC_RK = 3584, PC_RV = 4096, PC_RG = 4608, PC_LX = 5120, PC_LY = 5632, PC_GATE = 6144;
constexpr int OC_SB = 0, OC_MLA = 512, OC_RET = 1024, OC_LRU = 1536;

constexpr size_t MiB = 1u << 20;
constexpr size_t WS_CTL = 0, CTL_ZERO_BYTES = 1 * MiB;
constexpr size_t WS_WIN = 2 * MiB;
constexpr size_t WS_WUKV = 58 * MiB;
constexpr size_t WS_WBR = 59 * MiB;
constexpr size_t WS_WOUT = 67 * MiB;
constexpr size_t WS_WGU = 75 * MiB;
constexpr size_t WS_WDN = 119 * MiB;
constexpr size_t WS_WLRU = 141 * MiB;
constexpr size_t WS_ROPE = 142 * MiB;
constexpr size_t WS_H = 156 * MiB;
constexpr size_t WS_O = 220 * MiB;
constexpr size_t WS_MIXED = 284 * MiB;
constexpr size_t WS_KV = 348 * MiB;
constexpr size_t WS_MIXF = 380 * MiB;
constexpr size_t WS_P = 508 * MiB;
constexpr size_t WS_GT = 700 * MiB;
constexpr size_t WS_SSP = 956 * MiB;
constexpr size_t WS_X8 = 976 * MiB;
constexpr size_t WS_WG8 = 1008 * MiB;
constexpr size_t WS_END = 1024 * MiB;
constexpr int CW_TMO = 0, CW_Q = 1024, CW_BAR = 4096;
#define XCD_BAR_WORDS 3456
constexpr int MAX_LAUNCH = 16;
static_assert((CW_BAR + MAX_LAUNCH * XCD_BAR_WORDS) * 4 <= (int)CTL_ZERO_BYTES, "ctl");

constexpr int RING_OFF = 0, RING_BYTES = 131072;
constexpr int TBL_OFF = RING_BYTES;
constexpr int MISC_OFF = RING_BYTES + 4096;
constexpr int LDS_BYTES = 147456;
constexpr int NWAVES = 8;

#define LDS_WAIT() asm volatile("s_waitcnt lgkmcnt(0)" ::: "memory")
#define VM_WAIT() asm volatile("s_waitcnt vmcnt(0)" ::: "memory")
__device__ __forceinline__ unsigned f2bf(float f) { unsigned u = __builtin_bit_cast(unsigned, f); return (u + 0x7fffu + ((u >> 16) & 1u)) >> 16; }
__device__ __forceinline__ unsigned pk2(float lo, float hi) { return f2bf(lo) | (f2bf(hi) << 16); }
__device__ __forceinline__ float bf2f(unsigned short b) { return __builtin_bit_cast(float, ((unsigned)b) << 16); }
__device__ __forceinline__ float bflo(unsigned w) { return __builtin_bit_cast(float, w << 16); }
__device__ __forceinline__ float bfhi(unsigned w) { return __builtin_bit_cast(float, w & 0xffff0000u); }
typedef __bf16 bf16x2_t __attribute__((ext_vector_type(2)));
__device__ __forceinline__ unsigned cvt_pk_bf16(float lo, float hi) { const f32x2 v = {lo, hi}; const bf16x2_t b = __builtin_convertvector(v, bf16x2_t); return __builtin_bit_cast(unsigned, b); }
__device__ __forceinline__ unsigned pk4_fp8(float a, float b, float c, float d) { int r = 0; r = __builtin_amdgcn_cvt_pk_fp8_f32(a, b, r, false); r = __builtin_amdgcn_cvt_pk_fp8_f32(c, d, r, true); return (unsigned)r; }
constexpr float F8_WSCALE = 64.0f;
__device__ __forceinline__ float fast_exp2(float x) { return __builtin_amdgcn_exp2f(x); }
__device__ __forceinline__ float fast_log2(float x) { return __builtin_amdgcn_logf(x); }
__device__ __forceinline__ float fast_rcp(float x) { return __builtin_amdgcn_rcpf(x); }
__device__ __forceinline__ float sigmoidf_(float x) { return fast_rcp(1.0f + fast_exp2(-x * LOG2E)); }
__device__ __forceinline__ float siluf_(float x) { return x * sigmoidf_(x); }
__device__ __forceinline__ float gelu_tanh_(float x) { const float u = 0.7978845608028654f * (x + 0.044715f * x * x * x); return x * sigmoidf_(2.0f * u); }
__device__ __forceinline__ float lg2_gamma(int h) { return log2f(1.0f - exp2f(-5.0f - (float)h)); }

#define XB_TMO      128
#define XB_XCNT(j)  (256  + 64 * (j))
#define XB_XSUB(j)  (1280 + 64 * (j))
#define XB_XGEN(j)  (2304 + 64 * (j))
#define XB_TOP      3328
#define XB_TOPGEN   3392
#define XB_SPIN_CAP (1u << 21)
__device__ __forceinline__ unsigned xb_ld(unsigned* p)              { return __hip_atomic_load(p, __ATOMIC_RELAXED, __HIP_MEMORY_SCOPE_AGENT); }
__device__ __forceinline__ unsigned xb_add(unsigned* p, unsigned v) { return __hip_atomic_fetch_add(p, v, __ATOMIC_RELAXED, __HIP_MEMORY_SCOPE_AGENT); }
__device__ __forceinline__ unsigned xb_xcc_id() { return (unsigned)__builtin_amdgcn_s_getreg((3 << 11) | 20) & 0xFu; }
#define XB_SPIN(cond, bar) do { unsigned _sp = 0; while (cond) { __builtin_amdgcn_s_sleep(1); \
    if ((++_sp & 255u) == 0u) { if (xb_ld(&(bar)[XB_TMO])) break; if (_sp > XB_SPIN_CAP) { atomicAdd(&(bar)[XB_TMO], 1u); break; } } } } while (0)
struct XcdBarrier { unsigned* bar; unsigned x; volatile LAS unsigned* st; };
__device__ __forceinline__ XcdBarrier xcd_barrier_post(unsigned* bar, volatile LAS unsigned* st) {
    XcdBarrier b; b.bar = bar; b.x = xb_xcc_id(); b.st = st;
    if (threadIdx.x == 0) (void)xb_add(&bar[XB_XCNT(b.x)], 1u);
    return b;
}
__device__ __forceinline__ void xcd_barrier_complete(unsigned* bar, unsigned x, unsigned& nloc, unsigned& nx) {
    const unsigned G = gridDim.x * gridDim.y * gridDim.z;
    unsigned sum, cnt, mine, sp = 0u;
    for (;;) {
        sum = 0u; cnt = 0u; mine = 0u;
#pragma unroll
        for (unsigned j = 0; j < 16; ++j) { const unsigned c = xb_ld(&bar[XB_XCNT(j)]); sum += c; cnt += (c > 0u) ? 1u : 0u; mine = (j == x) ? c : mine; }
        if (sum == G) break;
        __builtin_amdgcn_s_sleep(1);
        if ((++sp & 255u) == 0u) { if (xb_ld(&bar[XB_TMO])) break; if (sp > XB_SPIN_CAP) { atomicAdd(&bar[XB_TMO], 1u); break; } }
    }
    nloc = mine > 0u ? mine : 1u; nx = cnt > 0u ? cnt : 1u;
}
__device__ __forceinline__ void xcd_barrier(const XcdBarrier& b) {
    asm volatile("s_waitcnt vmcnt(0)" ::: "memory");
    __syncthreads();
    if (threadIdx.x == 0) {
        unsigned* bar = b.bar;
        __builtin_amdgcn_s_waitcnt(0);
        unsigned nloc = b.st[0], nx = b.st[1];
        if (nloc == 0u) { xcd_barrier_complete(bar, b.x, nloc, nx); b.st[0] = nloc; b.st[1] = nx; }
        const unsigned old = xb_add(&bar[XB_XSUB(b.x)], 1u);
        const unsigned gen = old / nloc;
        if (old + 1u == (gen + 1u) * nloc) {
            __builtin_amdgcn_fence(__ATOMIC_RELEASE, "agent");
            asm volatile("s_waitcnt vmcnt(0)" ::: "memory");
            const unsigned og = xb_add(&bar[XB_TOP], 1u);
            const unsigned tg = og / nx;
            if (og + 1u == (tg + 1u) * nx) xb_add(&bar[XB_TOPGEN], 1u);
            else XB_SPIN(xb_ld(&bar[XB_TOPGEN]) == tg, bar);
            __builtin_amdgcn_fence(__ATOMIC_ACQUIRE, "agent");
            xb_add(&bar[XB_XGEN(b.x)], 1u);
            asm volatile("s_waitcnt vmcnt(0)" ::: "memory");
        } else {
            XB_SPIN(xb_ld(&bar[XB_XGEN(b.x)]) == gen, bar);
            __builtin_amdgcn_fence(__ATOMIC_ACQUIRE, "agent");
            asm volatile("s_waitcnt vmcnt(0)" ::: "memory");
        }
    }
    __syncthreads();
}

namespace pg8 {
constexpr int BM = 256, BK = 64, HALF = 128, HTB = HALF * BK * 2, STAGE_BYTES = 8 * HTB, NXCD = 8, WGM = 8;
__host__ __device__ __forceinline__ int lds_byte(int r, int c) { const int st = (r >> 4) * 2 + (c >> 5), rr = r & 15, cc = c & 31, ob = rr * 64 + cc * 2; return st * 1024 + (ob ^ (((ob >> 9) & 1) << 5)); }
__host__ __device__ __forceinline__ void stage_rc(int b, int& R, int& C) { const int st = b / 1024, sb = b % 1024, swz = sb ^ (((sb >> 9) & 1) << 5); R = (st >> 1) * 16 + swz / 64; C = (st & 1) * 32 + (swz % 64) / 2; }
__host__ __device__ __forceinline__ int perm32(int rho) { const int n = rho >> 4, i = rho & 15; return 8 * (i >> 2) + 4 * n + (i & 3); }
struct Unit { int pm, pn, sub; };
struct Gemm { const bf16* A; const bf16* Bt; int M, N, K, lda, ldb; size_t subA, subB; };
struct StaticOrder {
    int nM, nN, nwg, G, c;
    __host__ __device__ void init(int M_, int N_, int G_, int c_) { nM = M_ / BM; nN = N_ / BM; nwg = nM * nN; G = G_; c = c_; }
    __host__ __device__ bool next(int i, Unit& u) const {
        const long L = (long)i * G + c; if (L >= nwg) return false;
        int wgid = (int)L; { const int q = nwg / NXCD, r = nwg % NXCD, xcd = wgid % NXCD, off = wgid / NXCD; wgid = (xcd < r ? xcd * (q + 1) : r * (q + 1) + (xcd - r) * q) + off; }
        const int nig = WGM * nN, gid = wgid / nig, fm = gid * WGM, gsz = (nM - fm) < WGM ? (nM - fm) : WGM;
        u.pm = fm + ((wgid % nig) % gsz); u.pn = (wgid % nig) / gsz; u.sub = 0; return true;
    }
};
struct PairOrder { StaticOrder base;
    __host__ __device__ bool next(int i, Unit& u) const { if (!base.next(i >> 1, u)) return false; u.pn = 2 * u.pn + (i & 1); return true; } };
template <class B> struct RangeOrder { B base; int lo, hi;
    __host__ __device__ bool next(int i, Unit& u) const { return (lo + i < hi) && base.next(lo + i, u); } };
struct MergeOrder { StaticOrder base;
    __host__ __device__ bool next(int i, Unit& u) const { if (!base.next(i >> 2, u)) return false; u.sub = i & 3; return true; } };
typedef int v8i32 __attribute__((ext_vector_type(8)));
__device__ __forceinline__ v8i32 frag8(const bf16x8 lo, const bf16x8 hi) { const u32x4 a = __builtin_bit_cast(u32x4, lo), b = __builtin_bit_cast(u32x4, hi); return (v8i32){(int)a.x, (int)a.y, (int)a.z, (int)a.w, (int)b.x, (int)b.y, (int)b.z, (int)b.w}; }
template <class Epi, bool ALIGN_EPI = true, bool SP2 = true, class Sched = StaticOrder, bool F8 = false>
__device__ __forceinline__ void gemm_phase(LAS unsigned char* lds, const Gemm g, const Sched& S, const Epi& E, int tid_) {
    asm volatile("" : "+v"(tid_));
    const int tid = tid_, wid = __builtin_amdgcn_readfirstlane(tid >> 6), lane = tid & 63, wr = wid >> 2, wc = wid & 3, fr = lane & 15, fq = lane >> 4;
    const int K = g.K, nt = K / BK;
    unsigned voffA[2], voffB[2];
#pragma unroll
    for (int i = 0; i < 2; ++i) { int R, C; stage_rc(tid * 16 + i * 8192, R, C); const int Rb = Epi::PERM ? ((R & ~31) + perm32(R & 31)) : R;
        voffA[i] = (unsigned)(R * g.lda + C) * 2u; voffB[i] = (unsigned)(Rb * g.ldb + C) * 2u; }
    const size_t kstep = (size_t)(BK * 2);
    const size_t hstepA = (size_t)HALF * g.lda * 2, hstepB = (size_t)HALF * g.ldb * 2;
    const size_t tstepA = 2 * hstepA, tstepB = 2 * hstepB;
    const unsigned ldsw = (unsigned)wid * 1024u;
    const int aoff = lds_byte(wr * 64 + fr, fq * 8), boff = lds_byte(wc * 32 + fr, fq * 8);
#define PG8_SA(b, h) (((b) * 2 + (h)) * HTB)
#define PG8_SB(b, h) ((4 + (b) * 2 + (h)) * HTB)
#define PG8_STAGE(bufoff, gbase, voff) do { _Pragma("unroll") for (int _i = 0; _i < 2; ++_i) \
        __builtin_amdgcn_global_load_lds((const unsigned*)((const char*)(gbase) + (voff)[_i]), (LAS unsigned*)(lds + (bufoff) + ldsw + _i * 8192), 16, 0, 0); } while (0)
#define PG8_LDA(dst, b, h) do { _Pragma("unroll") for (int m = 0; m < 4; ++m) { if constexpr (F8) { const u32x4 lo_ = *(const LAS u32x4*)(lds + PG8_SA(b, h) + aoff + m * 2048), hi_ = *(const LAS u32x4*)(lds + PG8_SA(b, h) + aoff + 1024 + m * 2048); \
            dst##8[m] = (v8i32){(int)lo_.x, (int)lo_.y, (int)lo_.z, (int)lo_.w, (int)hi_.x, (int)hi_.y, (int)hi_.z, (int)hi_.w}; } \
        else { _Pragma("unroll") for (int k = 0; k < 2; ++k) dst[m][k] = *(const LAS bf16x8*)(lds + PG8_SA(b, h) + aoff + m * 2048 + k * 1024); } } } while (0)
#define PG8_LDB(dst, b, h) do { _Pragma("unroll") for (int n = 0; n < 2; ++n) { if constexpr (F8) { const u32x4 lo_ = *(const LAS u32x4*)(lds + PG8_SB(b, h) + boff + n * 2048), hi_ = *(const LAS u32x4*)(lds + PG8_SB(b, h) + boff + 1024 + n * 2048); \
            dst##8[n] = (v8i32){(int)lo_.x, (int)lo_.y, (int)lo_.z, (int)lo_.w, (int)hi_.x, (int)hi_.y, (int)hi_.z, (int)hi_.w}; } \
        else { _Pragma("unroll") for (int k = 0; k < 2; ++k) dst[n][k] = *(const LAS bf16x8*)(lds + PG8_SB(b, h) + boff + n * 2048 + k * 1024); } } } while (0)
#define PG8_MMA(ai, bj, At, Bt) do { __builtin_amdgcn_s_setprio(1); _Pragma("unroll") for (int m = 0; m < 4; ++m) _Pragma("unroll") for (int n = 0; n < 2; ++n) { \
        if constexpr (F8) asm volatile("v_mfma_scale_f32_16x16x128_f8f6f4 %0, %1, %2, %0, %3, %3 op_sel_hi:[0,0,0]" : "+v"(acc[ai][bj][m][n]) : "v"(Bt##8[n]), "v"(At##8[m]), "v"(sc1));   \
        else { _Pragma("unroll") for (int k = 0; k < 2; ++k) acc[ai][bj][m][n] = __builtin_amdgcn_mfma_f32_16x16x32_bf16(Bt[n][k], At[m][k], acc[ai][bj][m][n], 0, 0, 0); } } __builtin_amdgcn_s_setprio(0); } while (0)
#define PG8_WAIT_V(n) asm volatile("s_waitcnt vmcnt(" #n ")" ::: "memory")
#define PG8_WAIT_L(n) asm volatile("s_waitcnt lgkmcnt(" #n ")" ::: "memory")
#define PG8_BAR __builtin_amdgcn_s_barrier()
#define PG8_SCHED __builtin_amdgcn_sched_barrier(0)
    Unit cur, nxt; int ui = 0;
    if (!S.next(0, cur)) return;
    f32x4 acc[2][2][4][2];
#pragma unroll
    for (int a = 0; a < 2; ++a)
#pragma unroll
        for (int b = 0; b < 2; ++b)
#pragma unroll
            for (int m = 0; m < 4; ++m)
#pragma unroll
                for (int n = 0; n < 2; ++n) acc[a][b][m][n] = (f32x4){0.f, 0.f, 0.f, 0.f};
    bf16x8 At[4][2], B0[2][2], B1[2][2]; v8i32 At8[4], B08[2], B18[2];
    int sc1 = 0x7F7F7F7F; if constexpr (F8) asm volatile("" : "+v"(sc1));
    const char* cA = (const char*)g.A + (size_t)cur.pm * tstepA + (size_t)cur.sub * g.subA; const char* cB = (const char*)g.Bt + (size_t)cur.pn * tstepB + (size_t)cur.sub * g.subB;
    if constexpr (SP2) {
        PG8_STAGE(PG8_SB(0, 0), cB, voffB); PG8_STAGE(PG8_SB(0, 1), cB + hstepB, voffB); PG8_STAGE(PG8_SA(0, 0), cA, voffA); PG8_STAGE(PG8_SA(0, 1), cA + hstepA, voffA);
        if (wr == 1) PG8_BAR;
        PG8_WAIT_V(2); PG8_BAR;
        PG8_STAGE(PG8_SB(1, 0), cB + kstep, voffB); PG8_STAGE(PG8_SA(1, 0), cA + kstep, voffA); PG8_STAGE(PG8_SB(1, 1), cB + hstepB + kstep, voffB);
        PG8_WAIT_V(6); PG8_BAR;
    } else {
        PG8_STAGE(PG8_SB(0, 0), cB, voffB); PG8_STAGE(PG8_SA(0, 0), cA, voffA); PG8_STAGE(PG8_SB(0, 1), cB + hstepB, voffB); PG8_STAGE(PG8_SA(0, 1), cA + hstepA, voffA);
        if (wr == 1) PG8_BAR;
        PG8_WAIT_V(4); PG8_BAR;
        PG8_STAGE(PG8_SB(1, 0), cB + kstep, voffB); PG8_STAGE(PG8_SA(1, 0), cA + kstep, voffA); PG8_STAGE(PG8_SB(1, 1), cB + hstepB + kstep, voffB);
        PG8_WAIT_V(6); PG8_BAR;
    }
    for (;;) {
        const bool has_next = S.next(ui + 1, nxt);
        const char* nA = has_next ? (const char*)g.A + (size_t)nxt.pm * tstepA + (size_t)nxt.sub * g.subA : cA; const char* nB = has_next ? (const char*)g.Bt + (size_t)nxt.pn * tstepB + (size_t)nxt.sub * g.subB : cB;
        for (int t = 0; t < nt; t += 2) {
            const bool last = (t == nt - 2);
            const char* a1 = cA + (size_t)(t + 1) * kstep;
            const char* a2 = last ? nA : cA + (size_t)(t + 2) * kstep; const char* b2 = last ? nB : cB + (size_t)(t + 2) * kstep;
            const char* a3 = a2 + kstep; const char* b3 = b2 + kstep;
            if constexpr (SP2) {
            PG8_LDB(B0, 0, 0); PG8_LDB(B1, 0, 1); PG8_SCHED; PG8_LDA(At, 0, 0); PG8_STAGE(PG8_SA(1, 1), a1 + hstepA, voffA);
            PG8_WAIT_V(8); PG8_WAIT_L(0); PG8_BAR; PG8_MMA(0, 0, At, B0); PG8_MMA(0, 1, At, B1); PG8_BAR; PG8_SCHED;
            PG8_LDA(At, 0, 1); PG8_STAGE(PG8_SB(0, 0), b2, voffB); PG8_STAGE(PG8_SB(0, 1), b2 + hstepB, voffB); PG8_STAGE(PG8_SA(0, 0), a2, voffA);
            PG8_WAIT_V(8); PG8_WAIT_L(0); PG8_BAR; PG8_MMA(1, 0, At, B0); PG8_MMA(1, 1, At, B1); PG8_BAR; PG8_SCHED;
            PG8_LDB(B0, 1, 0); PG8_LDB(B1, 1, 1); PG8_SCHED; PG8_LDA(At, 1, 0); PG8_STAGE(PG8_SA(0, 1), a2 + hstepA, voffA);
            PG8_WAIT_V(8); PG8_WAIT_L(0); PG8_BAR; PG8_MMA(0, 0, At, B0); PG8_MMA(0, 1, At, B1); PG8_BAR; PG8_SCHED;
            PG8_LDA(At, 1, 1); PG8_STAGE(PG8_SB(1, 0), b3, voffB); PG8_STAGE(PG8_SB(1, 1), b3 + hstepB, voffB); PG8_STAGE(PG8_SA(1, 0), a3, voffA);
            PG8_WAIT_V(8); PG8_WAIT_L(0); PG8_BAR; PG8_MMA(1, 0, At, B0); PG8_MMA(1, 1, At, B1); PG8_BAR; PG8_SCHED;
            } else {
            PG8_LDB(B0, 0, 0); PG8_SCHED; PG8_LDA(At, 0, 0); PG8_STAGE(PG8_SA(1, 1), a1 + hstepA, voffA);
            PG8_WAIT_L(8); PG8_BAR; PG8_WAIT_L(0); PG8_MMA(0, 0, At, B0); PG8_BAR; PG8_SCHED;
            PG8_LDB(B1, 0, 1); PG8_STAGE(PG8_SB(0, 0), b2, voffB);
            PG8_BAR; PG8_WAIT_L(0); PG8_MMA(0, 1, At, B1); PG8_BAR;
            PG8_LDA(At, 0, 1); PG8_STAGE(PG8_SA(0, 0), a2, voffA);
            PG8_BAR; PG8_WAIT_L(0); PG8_MMA(1, 0, At, B0); PG8_BAR; PG8_SCHED;
            PG8_STAGE(PG8_SB(0, 1), b2 + hstepB, voffB);
            PG8_WAIT_V(6); PG8_BAR; PG8_MMA(1, 1, At, B1); PG8_BAR;
            PG8_LDB(B0, 1, 0); PG8_SCHED; PG8_LDA(At, 1, 0); PG8_STAGE(PG8_SA(0, 1), a2 + hstepA, voffA);
            PG8_WAIT_L(8); PG8_BAR; PG8_WAIT_L(0); PG8_MMA(0, 0, At, B0); PG8_BAR; PG8_SCHED;
            PG8_LDB(B1, 1, 1); PG8_STAGE(PG8_SB(1, 0), b3, voffB);
            PG8_BAR; PG8_WAIT_L(0); PG8_MMA(0, 1, At, B1); PG8_BAR;
            PG8_LDA(At, 1, 1); PG8_STAGE(PG8_SA(1, 0), a3, voffA);
            PG8_BAR; PG8_WAIT_L(0); PG8_MMA(1, 0, At, B0); PG8_BAR; PG8_SCHED;
            PG8_STAGE(PG8_SB(1, 1), b3 + hstepB, voffB);
            PG8_WAIT_V(6); PG8_BAR; PG8_MMA(1, 1, At, B1); PG8_BAR;
            }
        }
        if constexpr (ALIGN_EPI) { if (wr == 0) PG8_BAR; }
        if constexpr (F8) asm volatile("s_nop 15\n\ts_nop 15" ::: "memory");
        { int z_ = 0; asm volatile("" : "+v"(z_)); const int ln_ = (int)__builtin_amdgcn_mbcnt_hi(~0u, __builtin_amdgcn_mbcnt_lo(~0u, (unsigned)z_));
          E(acc, cur, ui, wr, wc, ln_ & 15, ln_ >> 4); }
        if (!has_next) break;
        if (Epi::zero_after(cur)) {
#pragma unroll
        for (int a = 0; a < 2; ++a)
#pragma unroll
            for (int b = 0; b < 2; ++b)
#pragma unroll
                for (int m = 0; m < 4; ++m)
#pragma unroll
                    for (int n = 0; n < 2; ++n) acc[a][b][m][n] = (f32x4){0.f, 0.f, 0.f, 0.f}; }
        cur = nxt; cA = nA; cB = nB; ++ui;
        if constexpr (ALIGN_EPI) { if (wr == 1) PG8_BAR; }
    }
    PG8_WAIT_V(0);
    if constexpr (!ALIGN_EPI) { if (wr == 0) PG8_BAR; }
    PG8_BAR;
#undef PG8_SA
#undef PG8_SB
#undef PG8_STAGE
#undef PG8_LDA
#undef PG8_LDB
#undef PG8_MMA
#undef PG8_WAIT_V
#undef PG8_WAIT_L
#undef PG8_BAR
#undef PG8_SCHED
}
}
using pg8::Unit;

typedef f32x4 (&AccRef)[2][2][4][2];
__device__ __forceinline__ u32x4 pack8(f32x4 v0, f32x4 v1) { u32x4 w; w.x = cvt_pk_bf16(v0[0], v0[1]); w.y = cvt_pk_bf16(v0[2], v0[3]); w.z = cvt_pk_bf16(v1[0], v1[1]); w.w = cvt_pk_bf16(v1[2], v1[3]); return w; }

struct RmsTab { const LAS float* tbl; int tag[4]; };
__device__ __forceinline__ void scale_rows_rms(AccRef acc, const RmsTab& T, int pm, int lr0, float pre = 1.0f) {
    const int slot = (pm == T.tag[0]) ? 0 : (pm == T.tag[1]) ? 1 : (pm == T.tag[2]) ? 2 : 3;
#pragma unroll
    for (int ai = 0; ai < 2; ++ai)
#pragma unroll
        for (int m = 0; m < 4; ++m) { const float rs = T.tbl[slot * 256 + lr0 + ai * 128 + m * 16] * pre;
#pragma unroll
            for (int bj = 0; bj < 2; ++bj) { acc[ai][bj][m][0] *= rs; acc[ai][bj][m][1] *= rs; } }
}
struct EpiInProj {
    static constexpr bool PERM = true; static __device__ __forceinline__ bool zero_after(const Unit&) { return true; }
    bf16* P; const float* c32; const float* s32; const float* c64; const float* s64; RmsTab T; int toff; float pre; float* css; const int* pos;
    __device__ __forceinline__ void operator()(AccRef acc, const Unit& u, int, int wr, int wc, int fr, int fq) const {
        const int t = u.pn + toff; const int row0 = u.pm * 256 + wr * 64 + fr; const int ch0 = wc * 32 + 8 * fq;
        scale_rows_rms(acc, T, u.pm, wr * 64 + fr, pre);
        bf16* base = P + (size_t)t * 256 + ch0;
        const bool rope = (t == 8) | (t == 11) | ((t >= 12) & (t < 16));
        if (!rope) {
            const int act = ((t == 18) | (t == 19)) ? 2 : ((t == 22) | (t == 23)) ? 3 : 0;
#pragma unroll
            for (int ai = 0; ai < 2; ++ai)
#pragma unroll
                for (int m = 0; m < 4; ++m) { bf16* rowp = base + (size_t)(row0 + ai * 128 + m * 16) * NP; float part = 0.f;
#pragma unroll
                    for (int bj = 0; bj < 2; ++bj) { f32x4 v0 = acc[ai][bj][m][0], v1 = acc[ai][bj][m][1];
                        part += (v0[0] * v0[0] + v0[1] * v0[1]) + (v0[2] * v0[2] + v0[3] * v0[3]) + (v1[0] * v1[0] + v1[1] * v1[1]) + (v1[2] * v1[2] + v1[3] * v1[3]);
                        if (act == 1) {
#pragma unroll
                            for (int j = 0; j < 4; ++j) { v0[j] = sigmoidf_(v0[j]); v1[j] = sigmoidf_(v1[j]); } }
                        else if (act == 2) {
#pragma unroll
                            for (int j = 0; j < 4; ++j) { v0[j] = siluf_(v0[j]); v1[j] = siluf_(v1[j]); } }
                        else if (act == 3) {
#pragma unroll
                            for (int j = 0; j < 4; ++j) { v0[j] = gelu_tanh_(v0[j]); v1[j] = gelu_tanh_(v1[j]); } }
                        *(u32x4*)(rowp + bj * 128) = pack8(v0, v1); }
                    if ((t == 9) | (t == 10)) { const int lane = fq * 16 + fr;
                        part += __builtin_bit_cast(float, __builtin_amdgcn_ds_bpermute((lane ^ 16) << 2, __builtin_bit_cast(int, part)));
                        part += __builtin_bit_cast(float, __builtin_amdgcn_ds_bpermute((lane ^ 32) << 2, __builtin_bit_cast(int, part)));
                        if (fq == 0) css[(size_t)(row0 + ai * 128 + m * 16) * 8 + (t - 9) * 4 + wc] = part; } }
        } else {
            const bool r64 = (t >= 12);
            const int nf = r64 ? 64 : 32;
            const int f0 = ch0 & (nf - 1);
            float frv[8];
#pragma unroll
            for (int j = 0; j < 8; ++j) frv[j] = fast_exp2((-13.287712379549449f / (float)nf) * (float)(f0 + j)) * 0.15915494309189535f;
            float lg = 0.f;
            if (r64) { const int hd = ((t - 12) & 1) * 2 + (ch0 >> 6); lg = lg2_gamma(hd) * ((t >= 14) ? -1.f : 1.f); }
#pragma unroll
            for (int ai = 0; ai < 2; ++ai)
#pragma unroll
                for (int m = 0; m < 4; ++m) { const int row = row0 + ai * 128 + m * 16; bf16* rowp = base + (size_t)row * NP;
                    const float fac = r64 ? fast_exp2(lg * (float)(row & 127)) : 1.f;
                    const float pf = (float)pos[row]; f32x4 ca, cb, sa, sb;
#pragma unroll
                    for (int j = 0; j < 4; ++j) { const float ta = __builtin_amdgcn_fractf(pf * frv[j]), tb = __builtin_amdgcn_fractf(pf * frv[4 + j]);
                        ca[j] = __builtin_amdgcn_cosf(ta); sa[j] = __builtin_amdgcn_sinf(ta); cb[j] = __builtin_amdgcn_cosf(tb); sb[j] = __builtin_amdgcn_sinf(tb); }
                    const f32x4 x1a = acc[ai][0][m][0], x1b = acc[ai][0][m][1], x2a = acc[ai][1][m][0], x2b = acc[ai][1][m][1];
                    f32x4 y1a, y1b, y2a, y2b;
#pragma unroll
                    for (int j = 0; j < 4; ++j) { y1a[j] = (x1a[j] * ca[j] - x2a[j] * sa[j]) * fac; y2a[j] = (x2a[j] * ca[j] + x1a[j] * sa[j]) * fac;
                                                  y1b[j] = (x1b[j] * cb[j] - x2b[j] * sb[j]) * fac; y2b[j] = (x2b[j] * cb[j] + x1b[j] * sb[j]) * fac; }
                    *(u32x4*)(rowp) = pack8(y1a, y1b); *(u32x4*)(rowp + 128) = pack8(y2a, y2b); }
        }
    }
};
struct EpiGate {
    static constexpr bool PERM = true; static __device__ __forceinline__ bool zero_after(const Unit&) { return true; }
    bf16* GT; RmsTab T; float pre;
    __device__ __forceinline__ void operator()(AccRef acc, const Unit& u, int, int wr, int wc, int fr, int fq) const {
        scale_rows_rms(acc, T, u.pm, wr * 64 + fr, pre);
        const int q = u.pn & 3, wcp = 2 * (q & 1) + (wc >> 1), fqp = 2 * (wc & 1) + (fq >> 1);
        bf16* base = GT + (size_t)((u.pm * 8 + (u.pn >> 2)) * 4) * 65536 + (size_t)((q >> 1) * 8) * 4096 + ((wr * 4 + wcp) * 64 + fqp * 16 + fr) * 8 + (fq & 1) * 4;
#pragma unroll
        for (int ai = 0; ai < 2; ++ai)
#pragma unroll
            for (int m = 0; m < 4; ++m) { bf16* sp = base + (ai * 4 + m) * 4096;
                f32x4 u0, v1, u2, g3;
#pragma unroll
                for (int i = 0; i < 4; ++i) {
                    const float d0 = 1.0f + fminf(fast_exp2(-acc[ai][0][m][0][i]), 1e30f), d1 = 1.0f + fminf(fast_exp2(-acc[ai][0][m][1][i]), 1e30f);
                    const float d2 = 1.0f + fminf(fast_exp2(-acc[ai][1][m][0][i]), 1e30f), d3 = 1.0f + fminf(fast_exp2(-acc[ai][1][m][1][i]), 1e30f);
                    u0[i] = d1 * fast_rcp(d0); v1[i] = d2 * fast_rcp(d1); u2[i] = d3 * fast_rcp(d2); g3[i] = fast_rcp(d3); }
                u32x2 w;
                w.x = cvt_pk_bf16(u0[0], u0[1]); w.y = cvt_pk_bf16(u0[2], u0[3]); *(u32x2*)(sp) = w;
                w.x = cvt_pk_bf16(v1[0], v1[1]); w.y = cvt_pk_bf16(v1[2], v1[3]); *(u32x2*)(sp + 65536) = w;
                w.x = cvt_pk_bf16(u2[0], u2[1]); w.y = cvt_pk_bf16(u2[2], u2[3]); *(u32x2*)(sp + 2 * 65536) = w;
                w.x = cvt_pk_bf16(g3[0], g3[1]); w.y = cvt_pk_bf16(g3[2], g3[3]); *(u32x2*)(sp + 3 * 65536) = w; }
    }
};
struct EpiKV {
    static constexpr bool PERM = true; static __device__ __forceinline__ bool zero_after(const Unit&) { return true; }
    bf16* KV; const LAS float* tbl;
    __device__ __forceinline__ void operator()(AccRef acc, const Unit& u, int ui, int wr, int wc, int fr, int fq) const {
        const int lr0 = wr * 64 + fr; const int col0 = u.pn * 256 + wc * 32 + 8 * fq;
#pragma unroll
        for (int ai = 0; ai < 2; ++ai)
#pragma unroll
            for (int m = 0; m < 4; ++m) { const int lr = lr0 + ai * 128 + m * 16; const float rs = tbl[(ui & 3) * 256 + lr]; bf16* rowp = KV + (size_t)(u.pm * 256 + lr) * 1024 + col0;
#pragma unroll
                for (int bj = 0; bj < 2; ++bj) *(u32x4*)(rowp + bj * 128) = pack8(acc[ai][bj][m][0] * rs, acc[ai][bj][m][1] * rs); }
    }
};
struct EpiMergeH {
    static constexpr bool PERM = true; static __device__ __forceinline__ bool zero_after(const Unit& u) { return u.sub == 3; }
    const bf16* G; bf16* mixed;
    static __device__ __forceinline__ void ld8(const bf16* p, f32x4& a, f32x4& b) { const u32x4 w = *(const u32x4*)p; a = (f32x4){bflo(w.x), bfhi(w.x), bflo(w.y), bfhi(w.y)}; b = (f32x4){bflo(w.z), bfhi(w.z), bflo(w.w), bfhi(w.w)}; }
    __device__ __forceinline__ void operator()(AccRef acc, const Unit& u, int, int wr, int wc, int fr, int fq) const {
        const int row0 = u.pm * 256 + wr * 64 + fr; const int ch0 = wc * 32 + 8 * fq; const int sub = u.sub; const int tid8 = ((wr * 4 + wc) * 64 + fq * 16 + fr) * 8;
        const bf16* g0 = G + (size_t)((u.pm * 8 + u.pn) * 4 + sub) * 65536 + tid8;
        u32x4 w[2][4][2];
#pragma unroll
        for (int ai = 0; ai < 2; ++ai)
#pragma unroll
            for (int m = 0; m < 4; ++m)
#pragma unroll
                for (int bj = 0; bj < 2; ++bj) w[ai][m][bj] = *(const u32x4*)(g0 + (bj * 8 + ai * 4 + m) * 4096);
#pragma unroll
        for (int ai = 0; ai < 2; ++ai)
#pragma unroll
            for (int m = 0; m < 4; ++m)
#pragma unroll
                for (int bj = 0; bj < 2; ++bj) { const u32x4 q = w[ai][m][bj];
                    acc[ai][bj][m][0] *= (f32x4){bflo(q.x), bfhi(q.x), bflo(q.y), bfhi(q.y)}; acc[ai][bj][m][1] *= (f32x4){bflo(q.z), bfhi(q.z), bflo(q.w), bfhi(q.w)}; }
        if (sub == 3) {
#pragma unroll
            for (int ai = 0; ai < 2; ++ai)
#pragma unroll
                for (int m = 0; m < 4; ++m) { const size_t row = (size_t)(row0 + ai * 128 + m * 16);
#pragma unroll
                    for (int bj = 0; bj < 2; ++bj) *(u32x4*)(mixed + row * DM + u.pn * 256 + bj * 128 + ch0) = pack8(acc[ai][bj][m][0], acc[ai][bj][m][1]); } }
    }
};
template <bool EARLY> struct EpiResidT {
    static constexpr bool PERM = true; static __device__ __forceinline__ bool zero_after(const Unit&) { return true; }
    bf16* X; float* SSout; unsigned char* X8;
    __device__ __forceinline__ void operator()(AccRef acc, const Unit& u, int, int wr, int wc, int fr, int fq) const {
        const int row0 = u.pm * 256 + wr * 64 + fr, col0 = u.pn * 256 + wc * 32 + 8 * fq; const int lane = fq * 16 + fr;
        u32x4 wx[4][2];
        auto ld_half = [&](int ai) {
#pragma unroll
            for (int m = 0; m < 4; ++m)
#pragma unroll
                for (int bj = 0; bj < 2; ++bj) wx[m][bj] = *(const u32x4*)(X + (size_t)(row0 + ai * 128 + m * 16) * DM + col0 + bj * 128); };
        auto add_half = [&](int ai) {
#pragma unroll
            for (int m = 0; m < 4; ++m)
#pragma unroll
                for (int bj = 0; bj < 2; ++bj) { const u32x4 w = wx[m][bj];
                    acc[ai][bj][m][0] += (f32x4){bflo(w.x), bfhi(w.x), bflo(w.y), bfhi(w.y)}; acc[ai][bj][m][1] += (f32x4){bflo(w.z), bfhi(w.z), bflo(w.w), bfhi(w.w)}; } };
        auto st_half = [&](int ai) {
#pragma unroll
            for (int m = 0; m < 4; ++m) { const int row = row0 + ai * 128 + m * 16; float part = 0.f;
#pragma unroll
                for (int bj = 0; bj < 2; ++bj) { bf16* p = X + (size_t)row * DM + col0 + bj * 128; const f32x4 v0 = acc[ai][bj][m][0], v1 = acc[ai][bj][m][1];
                    part += (v0[0] * v0[0] + v0[1] * v0[1]) + (v0[2] * v0[2] + v0[3] * v0[3]) + (v1[0] * v1[0] + v1[1] * v1[1]) + (v1[2] * v1[2] + v1[3] * v1[3]);
                    *(u32x4*)p = pack8(v0, v1);
                    if (X8) { u32x2 q; q.x = pk4_fp8(v0[0], v0[1], v0[2], v0[3]); q.y = pk4_fp8(v1[0], v1[1], v1[2], v1[3]); *(u32x2*)(X8 + (size_t)row * DM + col0 + bj * 128) = q; } }
                part += __builtin_bit_cast(float, __builtin_amdgcn_ds_bpermute((lane ^ 16) << 2, __builtin_bit_cast(int, part)));
                part += __builtin_bit_cast(float, __builtin_amdgcn_ds_bpermute((lane ^ 32) << 2, __builtin_bit_cast(int, part)));
                if (fq == 0) SSout[(size_t)row * 32 + u.pn * 4 + wc] = part; } };
        ld_half(0); add_half(0);
        if constexpr (EARLY) { ld_half(1); __builtin_amdgcn_sched_barrier(0); st_half(0); }
        else { st_half(0); ld_half(1); }
        add_half(1); st_half(1);
    }
};
typedef EpiResidT<false> EpiResid;
struct EpiSwiGLU {
    static constexpr bool PERM = true; static __device__ __forceinline__ bool zero_after(const Unit&) { return true; }
    bf16* HB; RmsTab T;
    __device__ __forceinline__ void operator()(AccRef acc, const Unit& u, int, int wr, int wc, int fr, int fq) const {
        const int row0 = u.pm * 256 + wr * 64 + fr; const int col0 = u.pn * 128 + wc * 32 + 8 * fq;
        scale_rows_rms(acc, T, u.pm, wr * 64 + fr);
#pragma unroll
        for (int ai = 0; ai < 2; ++ai)
#pragma unroll
            for (int m = 0; m < 4; ++m) { bf16* rowp = HB + (size_t)(row0 + ai * 128 + m * 16) * DFF + col0;
                f32x4 v0, v1;
#pragma unroll
                for (int j = 0; j < 4; ++j) { v0[j] = siluf_(acc[ai][0][m][0][j]) * acc[ai][1][m][0][j]; v1[j] = siluf_(acc[ai][0][m][1][j]) * acc[ai][1][m][1][j]; }
                *(u32x4*)rowp = pack8(v0, v1); }
    }
};


typedef float f32x16 __attribute__((ext_vector_type(16)));
typedef short s16x4 __attribute__((ext_vector_type(4)));
typedef LAS const unsigned char* lds_cptr;
__device__ __forceinline__ s16x4 vtr(lds_cptr p) { return __builtin_bit_cast(s16x4, __builtin_amdgcn_ds_read_tr16_b64_v4i16((LAS s16x4*)p)); }
__device__ __forceinline__ void pair_swap(float x, float& lo, float& hi) { auto rr = __builtin_amdgcn_permlane32_swap(__builtin_bit_cast(unsigned, x), __builtin_bit_cast(unsigned, x), false, false);
    const unsigned a = rr[0], b = rr[1]; lo = __builtin_bit_cast(float, a); hi = __builtin_bit_cast(float, b); }
__device__ __forceinline__ float pair_max(float x) { float a, b; pair_swap(x, a, b); return fmaxf(a, b); }
__device__ __forceinline__ float pair_sum(float x) { float a, b; pair_swap(x, a, b); return a + b; }
__device__ __forceinline__ bf16x8 pack_frag(const f32x16& p, int b0) { u32x4 w; w.x = cvt_pk_bf16(p[b0 + 0], p[b0 + 1]); w.y = cvt_pk_bf16(p[b0 + 2], p[b0 + 3]); w.z = cvt_pk_bf16(p[b0 + 4], p[b0 + 5]); w.w = cvt_pk_bf16(p[b0 + 6], p[b0 + 7]); return __builtin_bit_cast(bf16x8, w); }
constexpr int crow_c(int r) { return (r & 3) + 8 * (r >> 2); }

__device__ __forceinline__ float sb_block(f32x16& z, float Rbase, bool need_mask, int dq, int koff, int hi) {
    float sp[16];
#pragma unroll
    for (int r = 0; r < 16; ++r) { const float zz = z[r]; sp[r] = fmaxf(zz, 0.f) + fast_log2(1.0f + fast_exp2(-fabsf(zz))); if (need_mask && !(crow_c(r) + koff < dq)) sp[r] = 0.f; }
    float lo[4], hg[4];
#pragma unroll
    for (int a = 0; a < 4; ++a) { const float gs = (sp[4 * a] + sp[4 * a + 1]) + (sp[4 * a + 2] + sp[4 * a + 3]);
        pair_swap(gs, lo[a], hg[a]); }
    float SG[8]; float run = 0.f;
#pragma unroll
    for (int G = 7; G >= 0; --G) { SG[G] = run; run += (G & 1) ? hg[G >> 1] : lo[G >> 1]; }
#pragma unroll
    for (int a = 0; a < 4; ++a) { float C = Rbase + (hi ? SG[2 * a + 1] : SG[2 * a]);
#pragma unroll
        for (int i = 3; i >= 0; --i) { const int r = 4 * a + i; float wv = fast_exp2(z[r] - sp[r] - C); C += sp[r]; if (need_mask && !(crow_c(r) + koff < dq)) wv = 0.f; z[r] = wv; } }
    return run;
}

template <int MODE>
__device__ __forceinline__ void attn_unit(LAS unsigned char* lds, const bf16* P, const bf16* KV, bf16* O, int b, int h, int qb, int tid, unsigned* dbg = nullptr) {
    constexpr int DQK = MODE ? 192 : 128, NCH = DQK / 8, NKS = DQK / 16, KS = DQK * 2 + 16, VS = 320;
    constexpr int KBUF = 64 * KS, VBUF = 64 * VS, VOFF = 2 * KBUF, NKC = NCH * 64 / 512, EXOFF = 120 * 1024;
    const int lane = tid & 63, w = __builtin_amdgcn_readfirstlane(tid >> 6), l31 = lane & 31, hi = lane >> 5;
    const size_t rowb = (size_t)b * SEQ;
    const int q0 = qb * 256 + w * 32;
    bf16x8 qf[NKS];
    { const bf16* qrow = P + (rowb + q0 + l31) * NP;
#pragma unroll
      for (int ks = 0; ks < NKS; ++ks) { const bf16* src;
          if (MODE == 0) src = qrow + PC_SBQ + h * 128 + ks * 16 + 8 * hi;
          else if (ks < 8) src = qrow + PC_MQN + h * 128 + ks * 16 + 8 * hi;
          else if (ks < 10) src = qrow + PC_MQP + h * 32 + (ks - 8) * 16 + 8 * hi;
          else src = qrow + PC_MQP + 128 + h * 32 + (ks - 10) * 16 + 8 * hi;
          qf[ks] = *(const bf16x8*)src; } }
    const unsigned char* wsb = (const unsigned char*)P - WS_P;
    unsigned kp[NKC], vp[2]; int kw[NKC], vw[2]; unsigned kstride[NKC];
#pragma unroll
    for (int i = 0; i < NKC; ++i) { const int idx = tid + 512 * i, r = idx / NCH, c = idx % NCH; kw[i] = r * KS + c * 16;
        if (MODE == 0) { kp[i] = (unsigned)(WS_P + ((rowb + r) * NP + PC_SBK + h * 128 + c * 8) * 2); kstride[i] = 64u * NP * 2u; }
        else if (c < 16) { kp[i] = (unsigned)(WS_KV + ((rowb + r) * 1024 + h * 256 + c * 8) * 2); kstride[i] = 64u * 1024u * 2u; }
        else if (c < 20) { kp[i] = (unsigned)(WS_P + ((rowb + r) * NP + PC_KPE + (c - 16) * 8) * 2); kstride[i] = 64u * NP * 2u; }
        else { kp[i] = (unsigned)(WS_P + ((rowb + r) * NP + PC_KPE + 128 + (c - 20) * 8) * 2); kstride[i] = 64u * NP * 2u; } }
#pragma unroll
    for (int i = 0; i < 2; ++i) { const int idx = tid + 512 * i, r = idx >> 4, c = idx & 15; vw[i] = VOFF + r * VS + c * 16;
        vp[i] = MODE ? (unsigned)(WS_KV + ((rowb + r) * 1024 + h * 256 + 128 + c * 8) * 2) : (unsigned)(WS_P + ((rowb + r) * NP + PC_SBV + h * 128 + c * 8) * 2); }
    constexpr unsigned vstride = MODE ? 64u * 1024u * 2u : 64u * NP * 2u;
    const int njt = 4 * qb + 4;
    f32x16 o[4];
#pragma unroll
    for (int nb = 0; nb < 4; ++nb)
#pragma unroll
        for (int r = 0; r < 16; ++r) o[nb][r] = 0.f;
    float m_run = -1e30f, l_run = 0.f, Rsum = 0.f;
    if (MODE == 0 && tid < 3) *(volatile LAS unsigned*)(lds + EXOFF + 4 * tid) = 0u;
    u32x4 kreg[NKC], vreg[2];
    { const int jt = MODE ? 0 : njt - 1;
#pragma unroll
      for (int i = 0; i < NKC; ++i) kreg[i] = *(const u32x4*)(wsb + (kp[i] + (unsigned)jt * kstride[i]));
#pragma unroll
      for (int i = 0; i < 2; ++i) vreg[i] = *(const u32x4*)(wsb + (vp[i] + (unsigned)jt * vstride));
#pragma unroll
      for (int i = 0; i < NKC; ++i) *(LAS u32x4*)(lds + kw[i]) = kreg[i];
#pragma unroll
      for (int i = 0; i < 2; ++i) *(LAS u32x4*)(lds + vw[i]) = vreg[i];
    }
    __syncthreads();
#if DIAG
    if (dbg) {
        const int jt0 = MODE ? 0 : njt - 1; unsigned badv = 0, badk = 0, badt = 0;
        _Pragma("unroll") for (int i = 0; i < 2; ++i) { const u32x4 a = *(LAS u32x4*)(lds + vw[i]); const u32x4 g = *(const u32x4*)(wsb + (vp[i] + (unsigned)jt0 * vstride)); if (a.x != g.x || a.y != g.y || a.z != g.z || a.w != g.w) ++badv; }
        _Pragma("unroll") for (int i = 0; i < NKC; ++i) { const u32x4 a = *(LAS u32x4*)(lds + kw[i]); const u32x4 g = *(const u32x4*)(wsb + (kp[i] + (unsigned)jt0 * kstride[i])); if (a.x != g.x || a.y != g.y || a.z != g.z || a.w != g.w) ++badk; }
        { const lds_cptr vbx = (lds_cptr)lds + VOFF + (4 * hi + ((lane & 15) >> 2)) * VS + ((lane >> 4) & 1) * 32 + (lane & 3) * 8;
          _Pragma("unroll 1") for (int nb = 0; nb < 4; ++nb) _Pragma("unroll 1") for (int kk = 0; kk < 4; ++kk) _Pragma("unroll 1") for (int e = 0; e < 2; ++e) { const s16x4 v = vtr(vbx + (kk * 16 + 8 * e) * VS + nb * 64);
              _Pragma("unroll") for (int q = 0; q < 4; ++q) { const int key = jt0 * 64 + kk * 16 + 8 * e + 4 * hi + q; const bf16 g = MODE ? KV[(rowb + key) * 1024 + h * 256 + 128 + 32 * nb + l31] : P[(rowb + key) * NP + PC_SBV + h * 128 + 32 * nb + l31];
                  if ((unsigned short)v[q] != g) ++badt; } } }
        if (badv) atomicAdd(dbg + 440, badv); if (badk) atomicAdd(dbg + 441, badk); if (badt) atomicAdd(dbg + 442, badt); atomicAdd(dbg + 445, 1u);
    }
#endif
    const lds_cptr kb0 = (lds_cptr)lds + l31 * KS + hi * 16;
    const lds_cptr vb0 = (lds_cptr)lds + VOFF + (4 * hi + ((lane & 15) >> 2)) * VS + ((lane >> 4) & 1) * 32 + (lane & 3) * 8;
    for (int it = 0; it < njt; ++it) {
        const int jt = MODE ? it : njt - 1 - it, buf = it & 1;
        const bool more = (it + 1 < njt);
        if (more) { const int jn = MODE ? jt + 1 : jt - 1;
#pragma unroll
            for (int i = 0; i < NKC; ++i) kreg[i] = *(const u32x4*)(wsb + (kp[i] + (unsigned)jn * kstride[i]));
#pragma unroll
            for (int i = 0; i < 2; ++i) vreg[i] = *(const u32x4*)(wsb + (vp[i] + (unsigned)jn * vstride)); }
        const int k0 = jt * 64;
        const bool skip = NOSKIP ? false : (MODE ? (k0 > q0 + 31) : (k0 >= q0 + 31));
        if (!skip) {
            const bool need_mask = MODE ? (k0 + 63 > q0) : (k0 + 63 >= q0);
            const int dq = q0 + l31 - k0 - 4 * hi;
            f32x16 s0, s1;
#pragma unroll
            for (int r = 0; r < 16; ++r) { s0[r] = 0.f; s1[r] = 0.f; }
            const lds_cptr kb_ = kb0 + buf * KBUF;
            { bf16x8 kf0 = *(const LAS bf16x8*)(kb_), kf1 = *(const LAS bf16x8*)(kb_ + 32 * KS);
#pragma unroll
              for (int ks = 0; ks < NKS; ++ks) { bf16x8 nf0 = kf0, nf1 = kf1;
                  if (ks + 1 < NKS) { nf0 = *(const LAS bf16x8*)(kb_ + (ks + 1) * 32); nf1 = *(const LAS bf16x8*)(kb_ + 32 * KS + (ks + 1) * 32); }
                  s0 = __builtin_amdgcn_mfma_f32_32x32x16_bf16(kf0, qf[ks], s0, 0, 0, 0); s1 = __builtin_amdgcn_mfma_f32_32x32x16_bf16(kf1, qf[ks], s1, 0, 0, 0);
                  kf0 = nf0; kf1 = nf1; } }
            if (MODE == 0) {
                const float t1 = sb_block(s1, Rsum, need_mask, dq, 32, hi);
                const float t0 = sb_block(s0, Rsum + t1, need_mask, dq, 0, hi);
                Rsum += t1 + t0;
            } else {
#if DIAG_UNIFORM
#pragma unroll
                for (int r = 0; r < 16; ++r) { s0[r] = 0.f; s1[r] = 0.f; }
#endif
                if (need_mask) { const float NEG = -__builtin_inff();
#pragma unroll
                    for (int r = 0; r < 16; ++r) { if (!(crow_c(r) <= dq)) s0[r] = NEG; if (!(crow_c(r) + 32 <= dq)) s1[r] = NEG; } }
                float pm = s0[0];
#pragma unroll
                for (int r = 1; r < 16; ++r) pm = fmaxf(pm, s0[r]);
#pragma unroll
                for (int r = 0; r < 16; ++r) pm = fmaxf(pm, s1[r]);
                pm = pair_max(pm);
                float mn = m_run, alpha = 1.f;
                if (!__all(pm - m_run <= 8.0f)) {
                    mn = fmaxf(m_run, pm); alpha = fast_exp2(m_run - mn); m_run = mn;
#pragma unroll
                    for (int nb = 0; nb < 4; ++nb)
#pragma unroll
                        for (int r = 0; r < 16; ++r) o[nb][r] *= alpha; }
                float ps = 0.f;
#pragma unroll
                for (int r = 0; r < 16; ++r) { s0[r] = fast_exp2(s0[r] - mn); s1[r] = fast_exp2(s1[r] - mn); ps += s0[r] + s1[r]; }
                ps = pair_sum(ps); l_run = l_run * alpha + ps;
            }
            bf16x8 pa[4]; pa[0] = pack_frag(s0, 0); pa[1] = pack_frag(s0, 8); pa[2] = pack_frag(s1, 0); pa[3] = pack_frag(s1, 8);
#if DIAG
            if (dbg && it == 0 && w == 0 && (lane == 0 || lane == 32)) { unsigned nz = 0; _Pragma("unroll") for (int kk = 0; kk < 4; ++kk) _Pragma("unroll") for (int j = 0; j < 8; ++j) if (pa[kk][j] != 0) ++nz;
                atomicAdd(dbg + 443, nz); if (lane == 0) { dbg[444] = (unsigned)(l_run * 1000.0f); dbg[446] = (unsigned)(unsigned short)pa[0][0]; dbg[447] = (unsigned)(m_run * 100.0f + 10000.0f); } }
#endif
            const lds_cptr vb_ = vb0 + buf * VBUF;
            { s16x4 v0 = vtr(vb_), v1 = vtr(vb_ + 8 * VS);
#pragma unroll
              for (int st = 0; st < 16; ++st) { const int nb = st >> 2, kk = st & 3; s16x4 n0 = v0, n1 = v1;
                  if (st + 1 < 16) { const int nb2 = (st + 1) >> 2, kk2 = (st + 1) & 3; n0 = vtr(vb_ + (kk2 * 16) * VS + nb2 * 64); n1 = vtr(vb_ + (kk2 * 16 + 8) * VS + nb2 * 64); }
                  bf16x8 vf; vf[0] = v0[0]; vf[1] = v0[1]; vf[2] = v0[2]; vf[3] = v0[3]; vf[4] = v1[0]; vf[5] = v1[1]; vf[6] = v1[2]; vf[7] = v1[3];
                  o[nb] = __builtin_amdgcn_mfma_f32_32x32x16_bf16(vf, pa[kk], o[nb], 0, 0, 0);
                  v0 = n0; v1 = n1; } }
        }
        if (more) {
#pragma unroll
            for (int i = 0; i < NKC; ++i) *(LAS u32x4*)(lds + (buf ^ 1) * KBUF + kw[i]) = kreg[i];
#pragma unroll
            for (int i = 0; i < 2; ++i) *(LAS u32x4*)(lds + (buf ^ 1) * VBUF + vw[i]) = vreg[i]; }
        if (MODE == 0) {
            if (__all(Rsum > 160.f) && lane == 0) __hip_atomic_fetch_or((unsigned*)(lds + EXOFF) + (it % 3), 1u << w, __ATOMIC_RELAXED, __HIP_MEMORY_SCOPE_WORKGROUP);
            __syncthreads();
            const unsigned dm = *(volatile LAS unsigned*)(lds + EXOFF + 4 * (it % 3));
            if (tid == 0) *(volatile LAS unsigned*)(lds + EXOFF + 4 * ((it + 2) % 3)) = 0u;
            if (dm == 0xffu) break;
        } else __syncthreads();
    }
    const float inv = MODE ? fast_rcp(l_run) : 1.0f;
    bf16* orow = O + (rowb + q0 + l31) * DM + (MODE ? OC_MLA : OC_SB) + h * 128 + 4 * hi;
#pragma unroll
    for (int nb = 0; nb < 4; ++nb)
#pragma unroll
        for (int g4 = 0; g4 < 4; ++g4) { u32x2 wv; wv.x = cvt_pk_bf16(o[nb][4 * g4] * inv, o[nb][4 * g4 + 1] * inv); wv.y = cvt_pk_bf16(o[nb][4 * g4 + 2] * inv, o[nb][4 * g4 + 3] * inv);
            *(u32x2*)(orow + 32 * nb + 8 * g4) = wv; }
}


constexpr size_t MX_RKV = 0, MX_RSB = 32 * MiB, MX_LHL = 48 * MiB, MX_LCA = 80 * MiB, MX_LTA = 112 * MiB, MX_LTB = 112 * MiB + 512 * 1024, MX_LCR = 113 * MiB;
constexpr int TVS = 320;
constexpr float RET_GC = 128.0f;
__device__ __forceinline__ int ret_col(int hb, int ks, int hi) { return hb + 16 * ks + 8 * hi + (ks >= 4 ? 64 : 0); }
__device__ __forceinline__ bf16x8 tr_frag(lds_cptr p) { const s16x4 v0 = vtr(p), v1 = vtr(p + 8 * TVS); bf16x8 f; f[0] = v0[0]; f[1] = v0[1]; f[2] = v0[2]; f[3] = v0[3]; f[4] = v1[0]; f[5] = v1[1]; f[6] = v1[2]; f[7] = v1[3]; return f; }

__device__ __forceinline__ void ret_kv_item(LAS unsigned char* lds, const bf16* P, float* KVS, int item, int tid) {
    const int lane = tid & 63, w = __builtin_amdgcn_readfirstlane(tid >> 6), l31 = lane & 31, hi = lane >> 5;
    const int n = item & 15, h = (item >> 4) & 3, b = item >> 6;
    const size_t row0 = (size_t)b * SEQ + n * 128;
    const int hbk = PC_RK + (h >> 1) * 256 + (h & 1) * 64;
    constexpr int KOFF = 128 * TVS;
    { u32x4 sv[4], sk[4];
#pragma unroll
      for (int i = 0; i < 4; ++i) { const int idx = tid + 512 * i, r = idx >> 4, c = idx & 15; const bf16* rowp = P + (row0 + r) * NP;
          sv[i] = *(const u32x4*)(rowp + PC_RV + h * 128 + c * 8); sk[i] = *(const u32x4*)(rowp + hbk + (c < 8 ? c * 8 : 128 + (c - 8) * 8)); }
      __builtin_amdgcn_sched_barrier(0);
#pragma unroll
      for (int i = 0; i < 4; ++i) { const int idx = tid + 512 * i, r = idx >> 4, c = idx & 15;
          *(LAS u32x4*)(lds + r * TVS + c * 16) = sv[i]; *(LAS u32x4*)(lds + KOFF + r * TVS + c * 16) = sk[i]; } }
    __syncthreads();
    const lds_cptr tb = (lds_cptr)lds + (4 * hi + ((lane & 15) >> 2)) * TVS + ((lane >> 4) & 1) * 32 + (lane & 3) * 8;
#pragma unroll
    for (int tt = 0; tt < 2; ++tt) { const int ti = 2 * w + tt, dvt = ti >> 2, dt = ti & 3;
        f32x16 acc;
#pragma unroll
        for (int r = 0; r < 16; ++r) acc[r] = 0.f;
#pragma unroll
        for (int ks = 0; ks < 8; ++ks) { const bf16x8 af = tr_frag(tb + (16 * ks) * TVS + dvt * 64), bfr = tr_frag(tb + KOFF + (16 * ks) * TVS + dt * 64);
            acc = __builtin_amdgcn_mfma_f32_32x32x16_bf16(af, bfr, acc, 0, 0, 0); }
        bf16* op = (bf16*)KVS + (size_t)item * 16384 + (size_t)(32 * dvt + 4 * hi) * 128 + 32 * dt + l31;
#pragma unroll
        for (int r = 0; r < 16; ++r) op[(size_t)crow_c(r) * 128] = (bf16)f2bf(acc[r]); }
    __syncthreads();
}
__device__ __forceinline__ void ret_scan_item(const float* KVS, bf16* SB16, int item, int tid) {
    const int bh = item >> 2, qtr = item & 3, h = bh & 3; const size_t e0 = (size_t)qtr * 4096 + (size_t)tid * 8;
    const float lg = lg2_gamma(h), g1 = exp2f(lg), gC = exp2f(lg * RET_GC), gC1 = exp2f(lg * (RET_GC - 1.0f));
    f32x4 s0 = {0.f, 0.f, 0.f, 0.f}, s1 = {0.f, 0.f, 0.f, 0.f};
    f32x4 kv[15][2];
#pragma unroll
    for (int n = 0; n < 15; ++n) { const size_t off = ((size_t)bh * 16 + n) * 16384 + e0; const u32x4 w = *(const u32x4*)((const bf16*)KVS + off);
        kv[n][0] = (f32x4){bflo(w.x), bfhi(w.x), bflo(w.y), bfhi(w.y)}; kv[n][1] = (f32x4){bflo(w.z), bfhi(w.z), bflo(w.w), bfhi(w.w)}; }
#pragma unroll
    for (int n = 0; n < 16; ++n) { const size_t off = ((size_t)bh * 16 + n) * 16384 + e0;
        *(u32x4*)(SB16 + off) = pack8(s0 * g1, s1 * g1);
        if (n < 15) { s0 = s0 * gC + kv[n][0] * gC1; s1 = s1 * gC + kv[n][1] * gC1; } }
}
__device__ __forceinline__ void ret_out_item(LAS unsigned char* lds, const bf16* P, const bf16* SB16, bf16* O, int item, int tid) {
    const int lane = tid & 63, w = __builtin_amdgcn_readfirstlane(tid >> 6), l31 = lane & 31, hi = lane >> 5;
    const int pr = item & 7, bh = item >> 3, h = bh & 3, b = bh >> 2, ch = w >> 2, qg = w & 3, n = pr * 2 + ch;
    const size_t rowp0 = (size_t)b * SEQ + pr * 256;
    const size_t row0 = rowp0 + ch * 128;
    const int hbq = PC_RQ + (h >> 1) * 256 + (h & 1) * 64, hbk = PC_RK + (h >> 1) * 256 + (h & 1) * 64;
    constexpr int VT = 128 * TVS;
#pragma unroll
    for (int i = 0; i < 8; ++i) { const int idx = tid + 512 * i, r = idx >> 4, c = idx & 15;
        *(LAS u32x4*)(lds + r * TVS + c * 16) = *(const u32x4*)(P + (rowp0 + r) * NP + PC_RV + h * 128 + c * 8); }
    bf16x8 qf[8];
    { const bf16* qrow = P + (row0 + qg * 32 + l31) * NP;
#pragma unroll
      for (int ks = 0; ks < 8; ++ks) qf[ks] = *(const bf16x8*)(qrow + ret_col(hbq, ks, hi)); }
    __syncthreads();
    f32x16 o[4];
#pragma unroll
    for (int nb = 0; nb < 4; ++nb)
#pragma unroll
        for (int r = 0; r < 16; ++r) o[nb][r] = 0.f;
    const lds_cptr tb = (lds_cptr)lds + ch * VT + (4 * hi + ((lane & 15) >> 2)) * TVS + ((lane >> 4) & 1) * 32 + (lane & 3) * 8;
    for (int kb = 0; kb <= qg; ++kb) {
        f32x16 sc;
#pragma unroll
        for (int r = 0; r < 16; ++r) sc[r] = 0.f;
        const bf16* krow = P + (row0 + kb * 32 + l31) * NP;
#pragma unroll
        for (int ks = 0; ks < 8; ++ks) { const bf16x8 kf = *(const bf16x8*)(krow + ret_col(hbk, ks, hi)); sc = __builtin_amdgcn_mfma_f32_32x32x16_bf16(kf, qf[ks], sc, 0, 0, 0); }
        if (kb == qg) {
#pragma unroll
            for (int r = 0; r < 16; ++r) if (!(crow_c(r) + 4 * hi <= l31)) sc[r] = 0.f; }
        const bf16x8 p0 = pack_frag(sc, 0), p1 = pack_frag(sc, 8);
#pragma unroll
        for (int nb = 0; nb < 4; ++nb) { o[nb] = __builtin_amdgcn_mfma_f32_32x32x16_bf16(tr_frag(tb + (kb * 32) * TVS + nb * 64), p0, o[nb], 0, 0, 0);
                                         o[nb] = __builtin_amdgcn_mfma_f32_32x32x16_bf16(tr_frag(tb + (kb * 32 + 16) * TVS + nb * 64), p1, o[nb], 0, 0, 0); }
    }
    { const bf16* sbp = SB16 + ((size_t)bh * 16 + n) * 16384 + (size_t)l31 * 128 + 8 * hi;
#pragma unroll
      for (int nb = 0; nb < 4; ++nb)
#pragma unroll
          for (int ks = 0; ks < 8; ++ks) { const bf16x8 af = *(const bf16x8*)(sbp + (size_t)(32 * nb) * 128 + 16 * ks); o[nb] = __builtin_amdgcn_mfma_f32_32x32x16_bf16(af, qf[ks], o[nb], 0, 0, 0); } }
    float ss = 0.f;
#pragma unroll
    for (int nb = 0; nb < 4; ++nb)
#pragma unroll
        for (int r = 0; r < 16; ++r) ss += o[nb][r] * o[nb][r];
    ss = pair_sum(ss);
    const float rs = 1.0f / sqrtf(ss * (1.f / 128.f) + EPS);
    const size_t orow = row0 + qg * 32 + l31;
    const bf16* gp = P + orow * NP + PC_RG + h * 128 + 4 * hi; bf16* op = O + orow * DM + OC_RET + h * 128 + 4 * hi;
#pragma unroll
    for (int nb = 0; nb < 4; ++nb)
#pragma unroll
        for (int g4 = 0; g4 < 4; ++g4) { const u32x2 gw = *(const u32x2*)(gp + 32 * nb + 8 * g4);
            u32x2 wv; wv.x = cvt_pk_bf16(o[nb][4 * g4] * rs * bflo(gw.x), o[nb][4 * g4 + 1] * rs * bfhi(gw.x)); wv.y = cvt_pk_bf16(o[nb][4 * g4 + 2] * rs * bflo(gw.y), o[nb][4 * g4 + 3] * rs * bfhi(gw.y));
            *(u32x2*)(op + 32 * nb + 8 * g4) = wv; }
    __syncthreads();
}
struct LruParams { const float* cw; const float* cb; const float* ba; const float* bx; const float* lam; const bf16* WL; };
__device__ __forceinline__ void lru_local_item(LAS unsigned char* lds, const bf16* P, const LruParams& L, float* HL, float* CA, float* TA, float* TB, int item, int tid) {
    const int lane = tid & 63, w = __builtin_amdgcn_readfirstlane(tid >> 6), l31 = lane & 31, hi = lane >> 5;
    const int span = item & 15, blk = (item >> 4) & 3, b = item >> 6, t0 = span * 128;
    const size_t row0 = (size_t)b * SEQ + t0;
    constexpr int XS = 272;
    { const int c8 = tid & 15, tg = tid >> 4, ch0 = blk * 128 + c8 * 8;
      float xv[7][8];
#pragma unroll
      for (int j = 0; j < 7; ++j) { const int t = t0 + 4 * tg - 3 + j; u32x4 wv = {0u, 0u, 0u, 0u}; if (t >= 0) wv = *(const u32x4*)(P + ((size_t)b * SEQ + t) * NP + PC_LX + ch0);
          xv[j][0] = bflo(wv.x); xv[j][1] = bfhi(wv.x); xv[j][2] = bflo(wv.y); xv[j][3] = bfhi(wv.y); xv[j][4] = bflo(wv.z); xv[j][5] = bfhi(wv.z); xv[j][6] = bflo(wv.w); xv[j][7] = bfhi(wv.w); }
      float cwv[4][8], cbv[8];
#pragma unroll
      for (int tap = 0; tap < 4; ++tap) { const f32x4 a = *(const f32x4*)(L.cw + tap * 512 + ch0), c = *(const f32x4*)(L.cw + tap * 512 + ch0 + 4);
          cwv[tap][0] = a[0]; cwv[tap][1] = a[1]; cwv[tap][2] = a[2]; cwv[tap][3] = a[3]; cwv[tap][4] = c[0]; cwv[tap][5] = c[1]; cwv[tap][6] = c[2]; cwv[tap][7] = c[3]; }
      { const f32x4 a = *(const f32x4*)(L.cb + ch0), c = *(const f32x4*)(L.cb + ch0 + 4); cbv[0] = a[0]; cbv[1] = a[1]; cbv[2] = a[2]; cbv[3] = a[3]; cbv[4] = c[0]; cbv[5] = c[1]; cbv[6] = c[2]; cbv[7] = c[3]; }
#pragma unroll
      for (int tk = 0; tk < 4; ++tk) { float y[8];
#pragma unroll
          for (int e = 0; e < 8; ++e) { float a = cbv[e];
#pragma unroll
              for (int tap = 0; tap < 4; ++tap) a += xv[tk + tap][e] * cwv[tap][e];
              y[e] = a; }
          u32x4 o; o.x = cvt_pk_bf16(y[0], y[1]); o.y = cvt_pk_bf16(y[2], y[3]); o.z = cvt_pk_bf16(y[4], y[5]); o.w = cvt_pk_bf16(y[6], y[7]);
          *(LAS u32x4*)(lds + (4 * tg + tk) * XS + c8 * 16) = o; } }
    __syncthreads();
    const int cg = w & 3, th = w >> 2, chn = blk * 128 + cg * 32 + l31;
    f32x16 ra[2], rx[2];
#pragma unroll
    for (int tt = 0; tt < 2; ++tt)
#pragma unroll
        for (int r = 0; r < 16; ++r) { ra[tt][r] = 0.f; rx[tt][r] = 0.f; }
    { const bf16* wa = L.WL + (size_t)(blk * 128 + cg * 32 + l31) * 128 + 8 * hi; const bf16* wx = wa + 4 * 128 * 128;
      const lds_cptr xb = (lds_cptr)lds + (64 * th + l31) * XS + hi * 16;
#pragma unroll
      for (int ks = 0; ks < 8; ++ks) { const bf16x8 fa = *(const bf16x8*)(wa + 16 * ks), fx = *(const bf16x8*)(wx + 16 * ks);
#pragma unroll
          for (int tt = 0; tt < 2; ++tt) { const bf16x8 xf = *(const LAS bf16x8*)(xb + (32 * tt) * XS + ks * 32);
              ra[tt] = __builtin_amdgcn_mfma_f32_32x32x16_bf16(xf, fa, ra[tt], 0, 0, 0); rx[tt] = __builtin_amdgcn_mfma_f32_32x32x16_bf16(xf, fx, rx[tt], 0, 0, 0); } } }
    { const float bav = L.ba[chn], bxv = L.bx[chn], lm = L.lam[chn];
      const float spl = fmaxf(-lm, 0.f) + log1pf(expf(-fabsf(lm)));
      const float c8l = -8.0f * spl * LOG2E;
      const LAS bf16* xcol = (const LAS bf16*)(lds + (64 * th + 4 * hi) * XS) + cg * 32 + l31;
#pragma unroll
      for (int tt = 0; tt < 2; ++tt)
#pragma unroll
          for (int r = 0; r < 16; ++r) { const float rr_ = sigmoidf_(ra[tt][r] + bav), ii = sigmoidf_(rx[tt][r] + bxv);
              const float a = fast_exp2(c8l * rr_); const float xcv = bf2f(xcol[(32 * tt + crow_c(r)) * (XS / 2)]);
              ra[tt][r] = a; rx[tt][r] = sqrtf(fmaxf(1.0f - a * a, 0.f)) * (ii * xcv); } }
    float cinO[8], pinO[8]; float c = 0.f, p = 1.f;
#pragma unroll
    for (int tt = 0; tt < 2; ++tt)
#pragma unroll
        for (int a = 0; a < 4; ++a) { float Ag = 1.f, Bg = 0.f;
#pragma unroll
            for (int i = 0; i < 4; ++i) { const float av = ra[tt][4 * a + i]; Bg = av * Bg + rx[tt][4 * a + i]; Ag *= av; }
            float A0, A1, B0, B1; pair_swap(Ag, A0, A1); pair_swap(Bg, B0, B1);
            const float cm = A0 * c + B0, pm = p * A0;
            cinO[4 * tt + a] = hi ? cm : c; pinO[4 * tt + a] = hi ? pm : p;
            c = A1 * cm + B1; p = pm * A1; }
    const size_t rowb = row0 + 64 * th + 4 * hi;
#pragma unroll
    for (int tt = 0; tt < 2; ++tt)
#pragma unroll
        for (int a = 0; a < 4; ++a) { float hh = cinO[4 * tt + a], pp = pinO[4 * tt + a];
#pragma unroll
            for (int i = 0; i < 4; ++i) { const float av = ra[tt][4 * a + i]; hh = av * hh + rx[tt][4 * a + i]; pp *= av;
                const size_t o_ = (rowb + 32 * tt + 8 * a + i) * 512 + chn; ((bf16*)HL)[o_] = (bf16)f2bf(hh); ((bf16*)CA)[o_] = (bf16)f2bf(pp); } }
    if (hi == 0) { const size_t o_ = ((size_t)b * 32 + span * 2 + th) * 512 + chn; TA[o_] = p; TB[o_] = c; }
    __syncthreads();
}
__device__ __forceinline__ void lru_carry(const float* TA, const float* TB, float* CR, int gtid, int gstride) {
    for (int i = gtid; i < BATCH * 512; i += gstride) { const int b = i >> 9, chn = i & 511; float c = 0.f; float ta[32], tb[32];
#pragma unroll
        for (int ck = 0; ck < 32; ++ck) { const size_t o_ = ((size_t)b * 32 + ck) * 512 + chn; ta[ck] = TA[o_]; tb[ck] = TB[o_]; }
#pragma unroll
        for (int ck = 0; ck < 32; ++ck) { const size_t o_ = ((size_t)b * 32 + ck) * 512 + chn; CR[o_] = c; c = ta[ck] * c + tb[ck]; } }
}
__device__ __forceinline__ void lru_fix(const bf16* P, const float* HL, const float* CA, const float* CR, bf16* O, int gtid, int gstride, int iend) {
    for (int i = gtid; i < iend; i += gstride) { const int c8 = i & 63; const size_t row = (size_t)(i >> 6); const int b = (int)(row >> 11), t = (int)(row & (SEQ - 1));
        const size_t o_ = row * 512 + c8 * 8; const size_t cr = ((size_t)b * 32 + (t >> 6)) * 512 + c8 * 8;
        const u32x4 hw = *(const u32x4*)((const bf16*)HL + o_), aw = *(const u32x4*)((const bf16*)CA + o_); const f32x4 c0 = *(const f32x4*)(CR + cr), c1 = *(const f32x4*)(CR + cr + 4);
        const f32x4 h0 = {bflo(hw.x), bfhi(hw.x), bflo(hw.y), bfhi(hw.y)}, h1 = {bflo(hw.z), bfhi(hw.z), bflo(hw.w), bfhi(hw.w)}, a0 = {bflo(aw.x), bfhi(aw.x), bflo(aw.y), bfhi(aw.y)}, a1 = {bflo(aw.z), bfhi(aw.z), bflo(aw.w), bfhi(aw.w)};
        const u32x4 yw = *(const u32x4*)(P + row * NP + PC_LY + c8 * 8);
        const f32x4 y0 = {bflo(yw.x), bfhi(yw.x), bflo(yw.y), bfhi(yw.y)}, y1 = {bflo(yw.z), bfhi(yw.z), bflo(yw.w), bfhi(yw.w)};
        *(u32x4*)(O + row * DM + OC_LRU + c8 * 8) = pack8((h0 + a0 * c0) * y0, (h1 + a1 * c1) * y1); }
}

struct Args { const float* in[21]; float* out; unsigned char* ws; int ph_lo, ph_hi, li, pad; };
#define GIN(A_, i_) ((const float*)(const GAS float*)(A_).in[i_])
struct Frame {
    LAS unsigned char* lds; volatile LAS unsigned* MISC; gu32* ctl;
    int tid, lane, wave, G, bid;
    float* out; unsigned char* ws;
};
__device__ __forceinline__ float wave_sum(float v, int lane) {
#pragma unroll
    for (int o = 1; o < 64; o <<= 1) v += __builtin_bit_cast(float, __builtin_amdgcn_ds_bpermute((lane ^ o) << 2, __builtin_bit_cast(int, v)));
    return v;
}

__device__ __forceinline__ void transpose_item(const float* src, int ld, int col0, int k0, float scale, const float* kscale, bf16* dst, int K, LAS unsigned char* scr, int lane) {
    const int n4 = lane & 7, ks = lane >> 3;
    if (src) {
        f32x4 v[16];
        const float* sp = src + (size_t)(k0 + 16 * ks) * ld + col0 + 4 * n4;
#pragma unroll
        for (int i = 0; i < 16; ++i) v[i] = *(const GAS f32x4*)(sp + (size_t)i * ld);
        if (kscale) {
#pragma unroll
            for (int i = 0; i < 16; i += 4) { const f32x4 kk = *(const GAS f32x4*)(kscale + k0 + 16 * ks + i); v[i] *= kk[0]; v[i + 1] *= kk[1]; v[i + 2] *= kk[2]; v[i + 3] *= kk[3]; } }
#pragma unroll
        for (int j = 0; j < 4; ++j)
#pragma unroll
            for (int c = 0; c < 2; ++c) { u32x4 o;
                o.x = pk2(v[8 * c + 0][j] * scale, v[8 * c + 1][j] * scale); o.y = pk2(v[8 * c + 2][j] * scale, v[8 * c + 3][j] * scale);
                o.z = pk2(v[8 * c + 4][j] * scale, v[8 * c + 5][j] * scale); o.w = pk2(v[8 * c + 6][j] * scale, v[8 * c + 7][j] * scale);
                *(LAS u32x4*)(scr + (4 * n4 + j) * 272 + (16 * ks + 8 * c) * 2) = o; }
    } else {
#pragma unroll
        for (int j = 0; j < 4; ++j)
#pragma unroll
            for (int c = 0; c < 2; ++c) *(LAS u32x4*)(scr + (4 * n4 + j) * 272 + (16 * ks + 8 * c) * 2) = (u32x4){0u, 0u, 0u, 0u};
    }
    LDS_WAIT(); asm volatile("" ::: "memory");
    const int c16 = lane & 15, r4 = lane >> 4;
#pragma unroll
    for (int i = 0; i < 8; ++i) { const int n = r4 + 4 * i; const u32x4 o = *(const LAS u32x4*)(scr + n * 272 + c16 * 16); *(GAS u32x4*)(dst + (size_t)n * K + k0 + 8 * c16) = o; }
    LDS_WAIT(); asm volatile("" ::: "memory");
}
__device__ __forceinline__ void transpose_item8(const float* src, int ld, int col0, int k0, float scale, const float* kscale, unsigned char* dst, int K, LAS unsigned char* scr, int lane) {
    const int n4 = lane & 7, ks = lane >> 3;
    f32x4 v[16];
    const float* sp = src + (size_t)(k0 + 16 * ks) * ld + (size_t)(n4 & 1) * DM * DM + col0 + 4 * (n4 >> 1);
#pragma unroll
    for (int i = 0; i < 16; ++i) v[i] = *(const GAS f32x4*)(sp + (size_t)i * ld);
    if (kscale) {
#pragma unroll
        for (int i = 0; i < 16; i += 4) { const f32x4 kk = *(const GAS f32x4*)(kscale + k0 + 16 * ks + i); v[i] *= kk[0]; v[i + 1] *= kk[1]; v[i + 2] *= kk[2]; v[i + 3] *= kk[3]; } }
#pragma unroll
    for (int j = 0; j < 4; ++j) { u32x4 o;
        o.x = pk4_fp8(v[0][j] * scale, v[1][j] * scale, v[2][j] * scale, v[3][j] * scale); o.y = pk4_fp8(v[4][j] * scale, v[5][j] * scale, v[6][j] * scale, v[7][j] * scale);
        o.z = pk4_fp8(v[8][j] * scale, v[9][j] * scale, v[10][j] * scale, v[11][j] * scale); o.w = pk4_fp8(v[12][j] * scale, v[13][j] * scale, v[14][j] * scale, v[15][j] * scale);
        *(LAS u32x4*)(scr + (4 * n4 + j) * 144 + 16 * ks) = o; }
    LDS_WAIT(); asm volatile("" ::: "memory");
    const int c8 = lane & 7, r8 = lane >> 3;
#pragma unroll
    for (int i = 0; i < 4; ++i) { const int n = r8 + 8 * i; const u32x4 o = *(const LAS u32x4*)(scr + n * 144 + c8 * 16); *(GAS u32x4*)(dst + (size_t)n * K + k0 + 16 * c8) = o; }
    LDS_WAIT(); asm volatile("" ::: "memory");
}
__device__ __forceinline__ void map_inproj(int g, const float* w_in, const float* w_gate, const float*& src, int& ld, int& col, float& scale) {
    const int t = g >> 3, c = (g & 7) * 32, half = c >> 7, ch = c & 127;
    src = w_in; ld = INW; scale = 1.f; col = 0;
    const float SBS = 0.08838834764831845f * LOG2E, MLS = 0.07216878364870323f * LOG2E, RKS = 0.08838834764831845f;
    if (t < 6) { col = t * 256 + c; if (t < 2) scale = SBS; }
    else if (t < 8) { const int hd = (t - 6) * 2 + half; col = 1536 + hd * 192 + ch; scale = MLS; }
    else if (t == 8) { const int hd = ch >> 5; col = 1536 + hd * 192 + 128 + half * 32; scale = MLS; }
    else if (t < 11) { col = 2304 + (t - 9) * 256 + c; }
    else if (t == 11) { if (ch < 32) col = 2816 + half * 32; else src = nullptr; }
    else if (t < 14) { const int hd = (t - 12) * 2 + (ch >> 6); col = 2880 + hd * 128 + half * 64 + (ch & 63); }
    else if (t < 16) { const int hd = (t - 14) * 2 + (ch >> 6); col = 3392 + hd * 128 + half * 64 + (ch & 63); scale = RKS; }
    else if (t < 24) { col = 3904 + (t - 16) * 256 + c; }
    else { src = w_gate + (size_t)(2 * half) * DM * DM; ld = DM; col = (t - 24) * 64 + 16 * (ch >> 5); scale = LOG2E; }
}
__device__ __forceinline__ void phase_convert(Frame& F, const Args& A, int layer) {
    LAS unsigned char* scr = F.lds + RING_OFF + F.wave * 16384;
    const int gw = F.bid * NWAVES + F.wave, NGW = F.G * NWAVES, lane = F.lane;
    const float* w_in = GIN(A, 3) + (size_t)layer * DM * INW; const float* w_gate = GIN(A, 14) + (size_t)layer * 4 * DM * DM;
    const float* ln1g = GIN(A, 2) + layer * DM; const float* ln2g = GIN(A, 16) + layer * DM;
    const float* kvg = GIN(A, 4) + layer * 512; const float* w_ukv = GIN(A, 5) + (size_t)layer * 512 * 1024;
    const float* w_br = GIN(A, 13) + (size_t)layer * 4 * 512 * DM; const float* w_out = GIN(A, 15) + (size_t)layer * DM * DM;
    const float* w_fg = GIN(A, 17) + (size_t)layer * DM * DFF; const float* w_fu = GIN(A, 18) + (size_t)layer * DM * DFF; const float* w_fd = GIN(A, 19) + (size_t)layer * DFF * DM;
    const float* w_la = GIN(A, 8) + (size_t)layer * 4 * 128 * 128; const float* w_lx = GIN(A, 10) + (size_t)layer * 4 * 128 * 128;
    bf16* WIN = (bf16*)(F.ws + WS_WIN); bf16* WUKV = (bf16*)(F.ws + WS_WUKV); bf16* WBR = (bf16*)(F.ws + WS_WBR); bf16* WOUT = (bf16*)(F.ws + WS_WOUT);
    bf16* WGU = (bf16*)(F.ws + WS_WGU); bf16* WDN = (bf16*)(F.ws + WS_WDN); bf16* WLRU = (bf16*)(F.ws + WS_WLRU);
    constexpr int I_IN = 448 * 16, I_UKV = 32 * 4, I_BR = 256 * 4, I_OUT = 64 * 16, I_GU = 352 * 16, I_DN = 64 * 44, I_LRU = 2 * 16;
    constexpr int NITEMS = I_IN + I_UKV + I_BR + I_OUT + I_GU + I_DN + I_LRU;
    for (int it = gw; it < NITEMS; it += NGW) {
        int r = it;
        if (r < I_IN) { const int kb = r / 448, g = r % 448; const float* src; int ld, col; float sc; map_inproj(g, w_in, w_gate, src, ld, col, sc);
            if (g < 192) transpose_item(src, ld, col, kb * 128, sc, ln1g, WIN + (size_t)g * 32 * DM, DM, scr, lane);
            else transpose_item8(src, ld, col, kb * 128, sc * F8_WSCALE, ln1g, (unsigned char*)(F.ws + WS_WG8) + (size_t)(g - 192) * 32 * DM, DM, scr, lane);
            continue; } r -= I_IN;
        if (r < I_UKV) { const int kb = r / 32, g = r % 32; transpose_item(w_ukv, 1024, g * 32, kb * 128, 1.f, kvg, WUKV + (size_t)g * 32 * 512, 512, scr, lane); continue; } r -= I_UKV;
        if (r < I_BR) { const int kb = r / 256, g = r % 256, b = g >> 6; transpose_item(w_br + (size_t)b * 512 * DM, DM, (g & 63) * 32, kb * 128, 1.f, nullptr, WBR + (size_t)g * 32 * 512, 512, scr, lane); continue; } r -= I_BR;
        if (r < I_OUT) { const int kb = r / 64, g = r % 64; transpose_item(w_out, DM, g * 32, kb * 128, 1.f, nullptr, WOUT + (size_t)g * 32 * DM, DM, scr, lane); continue; } r -= I_OUT;
        if (r < I_GU) { const int kb = r / 352, g = r % 352, t = g >> 3, c32 = g & 7; const float* src = (c32 >> 2) ? w_fu : w_fg;
            transpose_item(src, DFF, t * 128 + (c32 & 3) * 32, kb * 128, 1.f, ln2g, WGU + (size_t)g * 32 * DM, DM, scr, lane); continue; } r -= I_GU;
        if (r < I_DN) { const int kb = r / 64, g = r % 64; transpose_item(w_fd, DM, g * 32, kb * 128, 1.f, nullptr, WDN + (size_t)g * 32 * DFF, DFF, scr, lane); continue; } r -= I_DN;
        { const int which = r >> 4, g = r & 15, kb = 0, hb = g >> 2; const float* src = (which ? w_lx : w_la) + (size_t)hb * 128 * 128;
            transpose_item(src, 128, (g & 3) * 32, kb * 128, 1.f, nullptr, WLRU + (size_t)which * 4 * 128 * 128 + (size_t)g * 32 * 128, 128, scr, lane); }
    }
}
__device__ __forceinline__ void phase_rope_tables(Frame& F, const Args& A) {
    const int* pos = (const int*)GIN(A, 1);
    float* c32 = (float*)(F.ws + WS_ROPE); float* s32 = c32 + (size_t)M * 32; float* c64 = s32 + (size_t)M * 32; float* s64 = c64 + (size_t)M * 64;
    const size_t n = (size_t)M * 96, stride = (size_t)F.G * 512;
    for (size_t i = (size_t)F.bid * 512 + F.tid; i < n; i += stride) {
        const int m = (int)(i / 96), j = (int)(i % 96);
        const float p = (float)pos[m];
        if (j < 32) { const float fr = powf(10000.0f, -(float)(2 * j) / 64.0f); float sn, cs; sincosf(p * fr, &sn, &cs); c32[(size_t)m * 32 + j] = cs; s32[(size_t)m * 32 + j] = sn; }
        else { const int jj = j - 32; const float fr = powf(10000.0f, -(float)(2 * jj) / 128.0f); float sn, cs; sincosf(p * fr, &sn, &cs); c64[(size_t)m * 64 + jj] = cs; s64[(size_t)m * 64 + jj] = sn; }
    }
}
__device__ __forceinline__ void phase_prep(Frame& F, const float* x, bf16* X16, float* SS0, unsigned char* X8) {
    const int gw = F.bid * NWAVES + F.wave, NGW = F.G * NWAVES;
    for (int m = gw; m < M; m += NGW) {
        const GAS f32x4* xr = (const GAS f32x4*)(x + (size_t)m * DM) + F.lane; GAS u32x2* o = (GAS u32x2*)(X16 + (size_t)m * DM) + F.lane;
        f32x4 v[8]; float s = 0.f;
#pragma unroll
        for (int j = 0; j < 8; ++j) { v[j] = xr[64 * j]; s += (v[j].x * v[j].x + v[j].y * v[j].y) + (v[j].z * v[j].z + v[j].w * v[j].w); }
#pragma unroll
        for (int j = 0; j < 8; ++j) { u32x2 w; w.x = pk2(v[j].x, v[j].y); w.y = pk2(v[j].z, v[j].w); o[64 * j] = w;
            ((GAS unsigned*)(X8 + (size_t)m * DM))[64 * j + F.lane] = pk4_fp8(v[j].x, v[j].y, v[j].z, v[j].w); }
        s = wave_sum(s, F.lane); if (F.lane < 32) SS0[(size_t)m * 32 + F.lane] = (F.lane == 0) ? s : 0.f;
    }
}
__device__ __forceinline__ void phase_final(Frame& F, const bf16* X16, const float* SS, const float* gain, float* out) {
    const int gw = F.bid * NWAVES + F.wave, NGW = F.G * NWAVES;
    f32x4 g0[4], g1[4];
#pragma unroll
    for (int j = 0; j < 4; ++j) { g0[j] = *(const f32x4*)(gain + 512 * j + 8 * F.lane); g1[j] = *(const f32x4*)(gain + 512 * j + 8 * F.lane + 4); }
    for (int m = gw; m < M; m += NGW) { const float rs = 1.0f / sqrtf(wave_sum((F.lane < 32) ? SS[(size_t)m * 32 + F.lane] : 0.f, F.lane) * (1.f / DM) + EPS);
        const GAS u32x4* xr = (const GAS u32x4*)(X16 + (size_t)m * DM) + F.lane; GAS f32x4* o = (GAS f32x4*)(out + (size_t)m * DM) + 2 * F.lane;
#pragma unroll
        for (int j = 0; j < 4; ++j) { const u32x4 w = xr[64 * j];
            o[128 * j] = (f32x4){bflo(w.x), bfhi(w.x), bflo(w.y), bfhi(w.y)} * rs * g0[j]; o[128 * j + 1] = (f32x4){bflo(w.z), bfhi(w.z), bflo(w.w), bfhi(w.w)} * rs * g1[j]; } }
}

template <class Sched>
__device__ __forceinline__ RmsTab rms_table(Frame& F, const Sched& S, const float* SSP, LAS float* tbl) {
    RmsTab T; T.tbl = tbl; T.tag[0] = T.tag[1] = T.tag[2] = T.tag[3] = -1; int n = 0; Unit u;
    for (int i = 0; S.next(i, u); ++i) { if (u.pm == T.tag[0] || u.pm == T.tag[1] || u.pm == T.tag[2] || u.pm == T.tag[3] || n >= 4) continue;
        const int r = F.tid >> 1, hf = F.tid & 1; const float* p = SSP + ((size_t)u.pm * 256 + r) * 32 + hf * 16;
        const f32x4 a = *(const f32x4*)p, b = *(const f32x4*)(p + 4), c = *(const f32x4*)(p + 8), d = *(const f32x4*)(p + 12);
        float sm = (((a[0] + a[1]) + (a[2] + a[3])) + ((b[0] + b[1]) + (b[2] + b[3]))) + (((c[0] + c[1]) + (c[2] + c[3])) + ((d[0] + d[1]) + (d[2] + d[3])));
        const float other = __builtin_bit_cast(float, __builtin_amdgcn_ds_bpermute((F.lane ^ 1) << 2, __builtin_bit_cast(int, sm)));
        sm = hf ? (other + sm) : (sm + other);
        if (hf == 0) tbl[n * 256 + r] = 1.0f / sqrtf(sm * (1.f / DM) + EPS);
        if (n == 0) T.tag[0] = u.pm; else if (n == 1) T.tag[1] = u.pm; else if (n == 2) T.tag[2] = u.pm; else T.tag[3] = u.pm;
        ++n; }
    LDS_WAIT(); __syncthreads();
    return T;
}

__global__ void __launch_bounds__(NWAVES * 64, 2) mega_fwd(Args args) {
    extern __shared__ __attribute__((aligned(16))) unsigned char lds[];
    Frame F;
    F.lds = (LAS unsigned char*)lds; F.MISC = (volatile LAS unsigned*)(F.lds + MISC_OFF);
    F.tid = threadIdx.x; F.lane = F.tid & 63; F.wave = __builtin_amdgcn_readfirstlane(F.tid >> 6); F.G = gridDim.x; F.bid = blockIdx.x;
    F.ws = (unsigned char*)(GAS unsigned char*)args.ws; F.ctl = (gu32*)(args.ws + WS_CTL); F.out = (float*)(GAS float*)args.out;
    for (int u = F.tid; u < (LDS_BYTES - MISC_OFF) / 4; u += NWAVES * 64) ((LAS unsigned*)(F.lds + MISC_OFF))[u] = 0u;
    __syncthreads();
    XcdBarrier bar = xcd_barrier_post((unsigned*)(F.ctl + CW_BAR) + args.li * XCD_BAR_WORDS, F.MISC + 8);
    const int lo = args.ph_lo, hi = args.ph_hi;
    const int wave_u = __builtin_amdgcn_readfirstlane((int)threadIdx.x >> 6);
#define IN(k) (lo <= (k) && (k) < hi)
#define SEAM(k) do { if (IN(k) && (k) + 1 < hi) xcd_barrier(bar); } while (0)
#define PHASE_BEGIN() { GAS unsigned char* w_ = (GAS unsigned char*)args.ws; asm volatile("" : "+s"(w_)); F.ws = (unsigned char*)w_; GAS float* o_ = (GAS float*)args.out; asm volatile("" : "+s"(o_)); F.out = (float*)o_; \
          F.ctl = (gu32*)(w_ + WS_CTL); int z_ = 0; asm volatile("" : "+v"(z_)); int wv_ = wave_u; asm volatile("" : "+s"(wv_)); \
          F.lane = (int)__builtin_amdgcn_mbcnt_hi(~0u, __builtin_amdgcn_mbcnt_lo(~0u, (unsigned)z_)); F.wave = wv_; F.tid = (wv_ << 6) | F.lane; }
#define WSP(T, off) ((T*)(F.ws + (off)))
    for (int layer = 0; layer < DEPTH; ++layer) {
        const int pb = layer * 10;
        if (IN(pb + 0)) { PHASE_BEGIN();
            phase_convert(F, args, layer);
            if (layer == 0) phase_prep(F, GIN(args, 0), WSP(bf16, WS_H), WSP(float, WS_SSP), WSP(unsigned char, WS_X8));
        }
        SEAM(pb + 0);
        if (IN(pb + 1)) { PHASE_BEGIN();
            pg8::Gemm g{WSP(bf16, WS_H), WSP(bf16, WS_WIN), M, 6144, DM, DM, DM, 0, 0}; pg8::StaticOrder S; S.init(M, 6144, F.G, F.bid);
            float* const c32 = WSP(float, WS_ROPE); float* const s32 = c32 + (size_t)M * 32; float* const c64 = s32 + (size_t)M * 32; float* const s64 = c64 + (size_t)M * 64;
            const RmsTab T = rms_table(F, S, WSP(float, WS_SSP) + (size_t)(2 * layer) * M * 32, (LAS float*)(F.lds + TBL_OFF));
            const int nfirst = 2 * ((F.bid & 7) >> 1);
#pragma unroll 1
            for (int part = 0; part < 3; ++part) {
              if (part == 1) { PHASE_BEGIN();
                EpiInProj E{WSP(bf16, WS_P), c32, s32, c64, s64, T, 0, 1.0f, WSP(float, WS_SSP) + (size_t)9 * M * 32, (const int*)GIN(args, 1)};
                pg8::gemm_phase<EpiInProj, true, true>(F.lds + RING_OFF, g, S, E, F.tid);
              } else { PHASE_BEGIN();
                pg8::Gemm g8{(const bf16*)WSP(unsigned char, WS_X8), (const bf16*)WSP(unsigned char, WS_WG8), M, 8192, DM / 2, DM / 2, DM / 2, 0, 0};
                pg8::RangeOrder<pg8::StaticOrder> S8; S8.base.init(M, 8192, F.G, F.bid); S8.lo = part ? nfirst : 0; S8.hi = part ? 1 << 20 : nfirst;
                EpiGate E8{WSP(bf16, WS_GT), T, 1.0f / F8_WSCALE};
                pg8::gemm_phase<EpiGate, true, true, pg8::RangeOrder<pg8::StaticOrder>, true>(F.lds + RING_OFF, g8, S8, E8, F.tid); }
            }
        }
        SEAM(pb + 1);
        if (IN(pb + 2)) { { PHASE_BEGIN();
            bf16* const P = WSP(bf16, WS_P);
            pg8::StaticOrder S; S.init(M, 1024, F.G, F.bid);
            LAS float* tbl = (LAS float*)(F.lds + TBL_OFF);
            { Unit u; const float* css = WSP(float, WS_SSP) + (size_t)9 * M * 32;
              for (int i = 0; i < 4 && S.next(i, u); ++i) if (F.tid < 256) { const float* q = css + (size_t)(u.pm * 256 + F.tid) * 8; const f32x4 a = *(const f32x4*)q, b = *(const f32x4*)(q + 4);
                  const float sm = ((a[0] + a[1]) + (a[2] + a[3])) + ((b[0] + b[1]) + (b[2] + b[3])); tbl[i * 256 + F.tid] = 1.0f / sqrtf(sm * (1.f / 512.f) + EPS); } }
            LDS_WAIT(); __syncthreads();
            pg8::Gemm g{P + PC_CKV, WSP(bf16, WS_WUKV), M, 1024, 512, NP, 512, 0, 0};
            EpiKV E{WSP(bf16, WS_KV), tbl};
            pg8::gemm_phase<EpiKV, true, true>(F.lds + RING_OFF, g, S, E, F.tid); }
#if RET_OPT
            { PHASE_BEGIN(); for (int it = F.bid; it < 512; it += F.G) ret_kv_item(F.lds + RING_OFF, WSP(bf16, WS_P), (float*)(F.ws + WS_MIXF + MX_RKV), it, F.tid); }
#endif
#if LRU_OPT
            { PHASE_BEGIN(); const LruParams LP{GIN(args, 6) + layer * 4 * 512, GIN(args, 7) + layer * 512, GIN(args, 9) + layer * 512, GIN(args, 11) + layer * 512, GIN(args, 12) + layer * 512, WSP(bf16, WS_WLRU)};
              for (int it = F.bid; it < 512; it += F.G) lru_local_item(F.lds + RING_OFF, WSP(bf16, WS_P), LP, (float*)(F.ws + WS_MIXF + MX_LHL), (float*)(F.ws + WS_MIXF + MX_LCA), (float*)(F.ws + WS_MIXF + MX_LTA), (float*)(F.ws + WS_MIXF + MX_LTB), it, F.tid); }
#endif
        }
        SEAM(pb + 2);
        if (IN(pb + 3)) { PHASE_BEGIN();
#if RET_OPT
            for (int it = F.bid; it < 128; it += F.G) ret_scan_item((const float*)(F.ws + WS_MIXF + MX_RKV), (bf16*)(F.ws + WS_MIXF + MX_RSB), it, F.tid);
#endif
#if LRU_OPT
            lru_carry((const float*)(F.ws + WS_MIXF + MX_LTA), (const float*)(F.ws + WS_MIXF + MX_LTB), (float*)(F.ws + WS_MIXF + MX_LCR), F.bid * 512 + F.tid, F.G * 512);
#endif
        }
        SEAM(pb + 3);
        if (IN(pb + 4)) {
            int qdone = 0;
#define QPULL(q) if (qdone & (1 << (q))) break; \
            if (F.tid == 0) { gu32* qh_ = F.ctl + CW_Q + (layer * 4) * 64; const unsigned it_ = __hip_atomic_fetch_add((unsigned*)(qh_ + (q) * 64), 1u, __ATOMIC_RELAXED, __HIP_MEMORY_SCOPE_AGENT); \
                const unsigned c0_ = xb_ld((unsigned*)qh_), c1_ = xb_ld((unsigned*)(qh_ + 64)), c2_ = xb_ld((unsigned*)(qh_ + 128)), c3_ = xb_ld((unsigned*)(qh_ + 192)); \
                F.MISC[16] = it_; F.MISC[17] = (c0_ >= 256u ? 1u : 0u) | (c1_ >= 256u ? 2u : 0u) | (c2_ >= 256u ? 4u : 0u) | (c3_ >= 256u ? 8u : 0u); } \
            __syncthreads(); const int item = (int)F.MISC[16]; qdone |= (int)F.MISC[17]; __syncthreads(); if (item >= 256) break
#if MLA_OPT
            { PHASE_BEGIN();
            for (;;) { QPULL(1);
                attn_unit<1>(F.lds + RING_OFF, WSP(bf16, WS_P), WSP(bf16, WS_KV), (DIAG && layer == 0) ? WSP(bf16, WS_MIXED) : WSP(bf16, WS_O), (item & 31) >> 2, item & 3, 7 - (item >> 5), F.tid); } }
#endif
#if SB_OPT
            { PHASE_BEGIN();
            for (;;) { QPULL(0);
                attn_unit<0>(F.lds + RING_OFF, WSP(bf16, WS_P), WSP(bf16, WS_KV), (DIAG && layer == 0) ? WSP(bf16, WS_MIXED) : WSP(bf16, WS_O), (item & 31) >> 2, item & 3, 7 - (item >> 5), F.tid); } }
#endif
#if RET_OPT
            { PHASE_BEGIN();
            for (;;) { QPULL(2);
                ret_out_item(F.lds + RING_OFF, WSP(bf16, WS_P), (const bf16*)(F.ws + WS_MIXF + MX_RSB), (DIAG && layer == 0) ? WSP(bf16, WS_MIXED) : WSP(bf16, WS_O), item, F.tid); } }
#endif
#if LRU_OPT
            { PHASE_BEGIN();
            for (;;) { QPULL(3);
                lru_fix(WSP(bf16, WS_P), (const float*)(F.ws + WS_MIXF + MX_LHL), (const float*)(F.ws + WS_MIXF + MX_LCA), (const float*)(F.ws + WS_MIXF + MX_LCR),
                        (DIAG && layer == 0) ? WSP(bf16, WS_MIXED) : WSP(bf16, WS_O), item * 4096 + F.tid, 512, (item + 1) * 4096); } }
#endif
#undef QPULL
        }
        SEAM(pb + 4);
        if (IN(pb + 5)) { PHASE_BEGIN();
            pg8::MergeOrder S; S.base.init(M, DM, F.G, F.bid);
            pg8::Gemm g{WSP(bf16, WS_O), WSP(bf16, WS_WBR), M, DM, 512, DM, 512, (size_t)512 * 2, (size_t)DM * 512 * 2};
            EpiMergeH E{WSP(bf16, WS_GT), WSP(bf16, WS_MIXED)};
            pg8::gemm_phase<EpiMergeH, true, true, pg8::MergeOrder>(F.lds + RING_OFF, g, S, E, F.tid);
        }
        SEAM(pb + 5);
        if (IN(pb + 6)) { PHASE_BEGIN();
            pg8::Gemm g{WSP(bf16, WS_MIXED), WSP(bf16, WS_WOUT), M, DM, DM, DM, DM, 0, 0}; pg8::StaticOrder S; S.init(M, DM, F.G, F.bid);
            EpiResidT<true> E{WSP(bf16, WS_H), WSP(float, WS_SSP) + (size_t)(2 * layer + 1) * M * 32, nullptr};
            if (args.pad) { E.X = WSP(bf16, WS_MIXF); E.SSout = WSP(float, WS_MIXF) + (size_t)20 * MiB; E.X8 = nullptr; }
            pg8::gemm_phase<EpiResidT<true>, true, true>(F.lds + RING_OFF, g, S, E, F.tid);
        }
        SEAM(pb + 6);
        if (IN(pb + 8)) { PHASE_BEGIN();
            pg8::Gemm g{WSP(bf16, WS_H), WSP(bf16, WS_WGU), M, 2 * DFF, DM, DM, DM, 0, 0}; pg8::StaticOrder S; S.init(M, 2 * DFF, F.G, F.bid);
            const RmsTab T = rms_table(F, S, WSP(float, WS_SSP) + (size_t)(2 * layer + 1) * M * 32, (LAS float*)(F.lds + TBL_OFF));
            EpiSwiGLU E{WSP(bf16, WS_P), T};
            pg8::gemm_phase<EpiSwiGLU, true, true>(F.lds + RING_OFF, g, S, E, F.tid);
        }
        SEAM(pb + 8);
        if (IN(pb + 9)) { PHASE_BEGIN();
            pg8::Gemm g{WSP(bf16, WS_P), WSP(bf16, WS_WDN), M, DM, DFF, DFF, DFF, 0, 0}; pg8::StaticOrder S; S.init(M, DM, F.G, F.bid);
            EpiResidT<true> E{WSP(bf16, WS_H), WSP(float, WS_SSP) + (size_t)(2 * layer + 2) * M * 32, (layer + 1 < DEPTH) ? WSP(unsigned char, WS_X8) : nullptr};
            if (args.pad) { E.X = WSP(bf16, WS_MIXF); E.SSout = WSP(float, WS_MIXF) + (size_t)20 * MiB; E.X8 = nullptr; }
            pg8::gemm_phase<EpiResidT<true>, true, true>(F.lds + RING_OFF, g, S, E, F.tid);
        }
        SEAM(pb + 9);
    }
    if (IN(40)) { PHASE_BEGIN(); phase_final(F, WSP(bf16, WS_H), WSP(float, WS_SSP) + (size_t)8 * M * 32, GIN(args, 20), F.out); }
#undef IN
#undef SEAM
}

#if NAIVE_MIX || DIAG
__global__ void __launch_bounds__(256) k_sb_naive(const bf16* __restrict__ P, bf16* __restrict__ O) {
    __shared__ __attribute__((aligned(16))) bf16 Ks[64][128]; __shared__ __attribute__((aligned(16))) bf16 Vs[64][128];
    const int qb = blockIdx.x & 31, h = (blockIdx.x >> 5) & 3, b = blockIdx.x >> 7;
    const int qi = threadIdx.x & 63, dc = threadIdx.x >> 6, t = qb * 64 + qi; const size_t row = (size_t)b * SEQ + t;
    float q[128];
#pragma unroll
    for (int d = 0; d < 128; d += 8) { const u32x4 w = *(const u32x4*)(P + row * NP + PC_SBQ + h * 128 + d);
        q[d] = bflo(w.x); q[d + 1] = bfhi(w.x); q[d + 2] = bflo(w.y); q[d + 3] = bfhi(w.y); q[d + 4] = bflo(w.z); q[d + 5] = bfhi(w.z); q[d + 6] = bflo(w.w); q[d + 7] = bfhi(w.w); }
    float o[32];
#pragma unroll
    for (int j = 0; j < 32; ++j) o[j] = 0.f;
    float R = 0.f;
    for (int kt = qb; kt >= 0; --kt) {
        __syncthreads();
        for (int c = threadIdx.x; c < 64 * 16; c += 256) { const int r = c >> 4, cc = (c & 15) * 8; const size_t kr = (size_t)b * SEQ + kt * 64 + r;
            *(u32x4*)&Ks[r][cc] = *(const u32x4*)(P + kr * NP + PC_SBK + h * 128 + cc); *(u32x4*)&Vs[r][cc] = *(const u32x4*)(P + kr * NP + PC_SBV + h * 128 + cc); }
        __syncthreads();
        for (int s = 63; s >= 0; --s) {
            float z = 0.f;
#pragma unroll
            for (int d = 0; d < 128; d += 8) { const u32x4 w = *(const u32x4*)&Ks[s][d];
                z += q[d] * bflo(w.x) + q[d + 1] * bfhi(w.x) + q[d + 2] * bflo(w.y) + q[d + 3] * bfhi(w.y) + q[d + 4] * bflo(w.z) + q[d + 5] * bfhi(w.z) + q[d + 6] * bflo(w.w) + q[d + 7] * bfhi(w.w); }
            const float sp = fmaxf(z, 0.f) + log2f(1.0f + exp2f(-fabsf(z)));
            if (kt * 64 + s < t) {
                const float w = exp2f(z - sp + R);
#pragma unroll
                for (int j = 0; j < 32; j += 8) { const u32x4 vv = *(const u32x4*)&Vs[s][dc * 32 + j];
                    o[j] += w * bflo(vv.x); o[j + 1] += w * bfhi(vv.x); o[j + 2] += w * bflo(vv.y); o[j + 3] += w * bfhi(vv.y); o[j + 4] += w * bflo(vv.z); o[j + 5] += w * bfhi(vv.z); o[j + 6] += w * bflo(vv.w); o[j + 7] += w * bfhi(vv.w); }
                R -= sp;
            }
        }
    }
#pragma unroll
    for (int j = 0; j < 32; j += 2) *(unsigned*)(O + row * DM + OC_SB + h * 128 + dc * 32 + j) = pk2(o[j], o[j + 1]);
}
__global__ void __launch_bounds__(256) k_mla_naive(const bf16* __restrict__ P, const bf16* __restrict__ KV, bf16* __restrict__ O) {
    __shared__ __attribute__((aligned(16))) bf16 Ks[64][192]; __shared__ __attribute__((aligned(16))) bf16 Vs[64][128];
    const int qb = blockIdx.x & 31, h = (blockIdx.x >> 5) & 3, b = blockIdx.x >> 7;
    const int qi = threadIdx.x & 63, dc = threadIdx.x >> 6, t = qb * 64 + qi; const size_t row = (size_t)b * SEQ + t;
    float q[192];
#pragma unroll
    for (int d = 0; d < 192; d += 8) { const bf16* src = (d < 128) ? (P + row * NP + PC_MQN + h * 128 + d) : (d < 160) ? (P + row * NP + PC_MQP + h * 32 + (d - 128)) : (P + row * NP + PC_MQP + 128 + h * 32 + (d - 160));
        const u32x4 w = *(const u32x4*)src;
        q[d] = bflo(w.x); q[d + 1] = bfhi(w.x); q[d + 2] = bflo(w.y); q[d + 3] = bfhi(w.y); q[d + 4] = bflo(w.z); q[d + 5] = bfhi(w.z); q[d + 6] = bflo(w.w); q[d + 7] = bfhi(w.w); }
    float o[32];
#pragma unroll
    for (int j = 0; j < 32; ++j) o[j] = 0.f;
    float mx = -1e30f, l = 0.f;
    for (int kt = 0; kt <= qb; ++kt) {
        __syncthreads();
        for (int c = threadIdx.x; c < 64 * 24; c += 256) { const int r = c / 24, cc = (c % 24) * 8; const size_t kr = (size_t)b * SEQ + kt * 64 + r;
            const bf16* src = (cc < 128) ? (KV + kr * 1024 + h * 256 + cc) : (cc < 160) ? (P + kr * NP + PC_KPE + (cc - 128)) : (P + kr * NP + PC_KPE + 128 + (cc - 160));
            *(u32x4*)&Ks[r][cc] = *(const u32x4*)src; }
        for (int c = threadIdx.x; c < 64 * 16; c += 256) { const int r = c >> 4, cc = (c & 15) * 8; const size_t kr = (size_t)b * SEQ + kt * 64 + r;
            *(u32x4*)&Vs[r][cc] = *(const u32x4*)(KV + kr * 1024 + h * 256 + 128 + cc); }
        __syncthreads();
        for (int s = 0; s < 64; ++s) {
            float z = 0.f;
#pragma unroll
            for (int d = 0; d < 192; d += 8) { const u32x4 w = *(const u32x4*)&Ks[s][d];
                z += q[d] * bflo(w.x) + q[d + 1] * bfhi(w.x) + q[d + 2] * bflo(w.y) + q[d + 3] * bfhi(w.y) + q[d + 4] * bflo(w.z) + q[d + 5] * bfhi(w.z) + q[d + 6] * bflo(w.w) + q[d + 7] * bfhi(w.w); }
#if DIAG_UNIFORM
            z = 0.f;
#endif
            if (kt * 64 + s <= t) {
                const float mn = fmaxf(mx, z), al = exp2f(mx - mn), p = exp2f(z - mn); mx = mn; l = l * al + p;
#pragma unroll
                for (int j = 0; j < 32; j += 8) { const u32x4 vv = *(const u32x4*)&Vs[s][dc * 32 + j];
                    o[j] = o[j] * al + p * bflo(vv.x); o[j + 1] = o[j + 1] * al + p * bfhi(vv.x); o[j + 2] = o[j + 2] * al + p * bflo(vv.y); o[j + 3] = o[j + 3] * al + p * bfhi(vv.y);
                    o[j + 4] = o[j + 4] * al + p * bflo(vv.z); o[j + 5] = o[j + 5] * al + p * bfhi(vv.z); o[j + 6] = o[j + 6] * al + p * bflo(vv.w); o[j + 7] = o[j + 7] * al + p * bfhi(vv.w); }
            }
        }
    }
    const float il = 1.0f / l;
#pragma unroll
    for (int j = 0; j < 32; j += 2) *(unsigned*)(O + row * DM + OC_MLA + h * 128 + dc * 32 + j) = pk2(o[j] * il, o[j + 1] * il);
}
__global__ void __launch_bounds__(256) k_ret_naive(const bf16* __restrict__ P, bf16* __restrict__ O) {
    __shared__ __attribute__((aligned(16))) bf16 Ks[64][128]; __shared__ __attribute__((aligned(16))) bf16 Vs[64][128]; __shared__ float ssq[64][4];
    const int qb = blockIdx.x & 31, h = (blockIdx.x >> 5) & 3, b = blockIdx.x >> 7;
    const int qi = threadIdx.x & 63, dc = threadIdx.x >> 6, t = qb * 64 + qi; const size_t row = (size_t)b * SEQ + t;
    const int hb = (h >> 1) * 256 + (h & 1) * 64;
    float q[128];
#pragma unroll
    for (int d = 0; d < 128; d += 8) { const u32x4 w = *(const u32x4*)(P + row * NP + PC_RQ + hb + ((d < 64) ? d : 128 + (d - 64)));
        q[d] = bflo(w.x); q[d + 1] = bfhi(w.x); q[d + 2] = bflo(w.y); q[d + 3] = bfhi(w.y); q[d + 4] = bflo(w.z); q[d + 5] = bfhi(w.z); q[d + 6] = bflo(w.w); q[d + 7] = bfhi(w.w); }
    float o[32];
#pragma unroll
    for (int j = 0; j < 32; ++j) o[j] = 0.f;
    const float lg = lg2_gamma(h);
    for (int kt = 0; kt <= qb; ++kt) {
        __syncthreads();
        for (int c = threadIdx.x; c < 64 * 16; c += 256) { const int r = c >> 4, cc = (c & 15) * 8; const size_t kr = (size_t)b * SEQ + kt * 64 + r;
            *(u32x4*)&Ks[r][cc] = *(const u32x4*)(P + kr * NP + PC_RK + hb + ((cc < 64) ? cc : 128 + (cc - 64))); *(u32x4*)&Vs[r][cc] = *(const u32x4*)(P + kr * NP + PC_RV + h * 128 + cc); }
        __syncthreads();
        const float cf = exp2f(lg * 128.0f * (float)((t >> 7) - (kt >> 1)));
        for (int s = 0; s < 64; ++s) {
            float z = 0.f;
#pragma unroll
            for (int d = 0; d < 128; d += 8) { const u32x4 w = *(const u32x4*)&Ks[s][d];
                z += q[d] * bflo(w.x) + q[d + 1] * bfhi(w.x) + q[d + 2] * bflo(w.y) + q[d + 3] * bfhi(w.y) + q[d + 4] * bflo(w.z) + q[d + 5] * bfhi(w.z) + q[d + 6] * bflo(w.w) + q[d + 7] * bfhi(w.w); }
            if (kt * 64 + s <= t) { const float w = z * cf;
#pragma unroll
                for (int j = 0; j < 32; j += 8) { const u32x4 vv = *(const u32x4*)&Vs[s][dc * 32 + j];
                    o[j] += w * bflo(vv.x); o[j + 1] += w * bfhi(vv.x); o[j + 2] += w * bflo(vv.y); o[j + 3] += w * bfhi(vv.y); o[j + 4] += w * bflo(vv.z); o[j + 5] += w * bfhi(vv.z); o[j + 6] += w * bflo(vv.w); o[j + 7] += w * bfhi(vv.w); }
            }
        }
    }
    float ss = 0.f;
#pragma unroll
    for (int j = 0; j < 32; ++j) ss += o[j] * o[j];
    ssq[qi][dc] = ss; __syncthreads();
    const float rs = 1.0f / sqrtf((ssq[qi][0] + ssq[qi][1] + ssq[qi][2] + ssq[qi][3]) * (1.f / 128.f) + EPS);
#pragma unroll
    for (int j = 0; j < 32; j += 2) { const unsigned gw = *(const unsigned*)(P + row * NP + PC_RG + h * 128 + dc * 32 + j);
        *(unsigned*)(O + row * DM + OC_RET + h * 128 + dc * 32 + j) = pk2(o[j] * rs * bflo(gw), o[j + 1] * rs * bfhi(gw)); }
}
__global__ void __launch_bounds__(256) k_lru_conv(const bf16* __restrict__ P, const float* __restrict__ cw, const float* __restrict__ cb, float* __restrict__ XC) {
    const size_t i = (size_t)blockIdx.x * 256 + threadIdx.x; const int c = (int)(i & 511); const size_t row = i >> 9; const int t = (int)(row & (SEQ - 1));
    float acc = cb[c];
#pragma unroll
    for (int tap = 0; tap < 4; ++tap) { const int tt = t - 3 + tap; if (tt >= 0) acc += bf2f(P[(row - 3 + tap) * NP + PC_LX + c]) * cw[tap * 512 + c]; }
    XC[i] = acc;
}
__global__ void __launch_bounds__(256) k_lru_gates(const float* __restrict__ XC, const float* __restrict__ wa, const float* __restrict__ ba, const float* __restrict__ wx, const float* __restrict__ bx,
                                                   const float* __restrict__ lam, float* __restrict__ Aout, float* __restrict__ Bout) {
    const size_t i = (size_t)blockIdx.x * 256 + threadIdx.x; const int c = (int)(i & 511); const size_t row = i >> 9; const int blk = c >> 7, cc = c & 127;
    const float* xr = XC + row * 512 + blk * 128; const float* wap = wa + (size_t)blk * 128 * 128 + cc; const float* wxp = wx + (size_t)blk * 128 * 128 + cc;
    float ra = ba[c], ri = bx[c];
    for (int k = 0; k < 128; ++k) { const float xv = xr[k]; ra += xv * wap[k * 128]; ri += xv * wxp[k * 128]; }
    const float r = 1.0f / (1.0f + expf(-ra)), ig = 1.0f / (1.0f + expf(-ri));
    const float lm = lam[c]; const float sp = fmaxf(-lm, 0.f) + log1pf(expf(-fabsf(lm)));
    const float log_a = -8.0f * r * sp; const float a = expf(log_a); const float mult = sqrtf(-expm1f(2.0f * log_a));
    Aout[i] = a; Bout[i] = mult * (ig * XC[i]);
}
__global__ void __launch_bounds__(64) k_lru_scan(const float* __restrict__ Ain, const float* __restrict__ Bin, const bf16* __restrict__ P, bf16* __restrict__ O) {
    const int i = blockIdx.x * 64 + threadIdx.x; const int c = i & 511, b = i >> 9;
    float hst = 0.f;
    for (int t = 0; t < SEQ; ++t) { const size_t row = (size_t)b * SEQ + t; hst = Ain[row * 512 + c] * hst + Bin[row * 512 + c];
        O[row * DM + OC_LRU + c] = (bf16)f2bf(hst * bf2f(P[row * NP + PC_LY + c])); }
}


__global__ void k_diag(const bf16* __restrict__ A, const bf16* __restrict__ B, int col0, float tol, unsigned* res) {
    const int row = blockIdx.x; const int c = threadIdx.x;
    const float a = bf2f(A[(size_t)row * DM + col0 + c]), b = bf2f(B[(size_t)row * DM + col0 + c]);
    const float d = fabsf(a - b); const bool bad = !(d <= tol * (1.0f + fabsf(a)));
    __shared__ unsigned nb;
    if (c == 0) nb = 0; __syncthreads();
    if (bad) { atomicAdd(&nb, 1u); atomicMax(res + 2, __builtin_bit_cast(unsigned, d)); }
    __syncthreads();
    if (c == 0 && nb) { atomicAdd(res + 0, 1u); atomicMin(res + 1, (unsigned)row); atomicAdd(res + 3, nb); const int t = row & (SEQ - 1);
        atomicAdd(res + 8 + (t >> 5), 1u);
        atomicAdd(res + 300 + (row >> 11), 1u); atomicAdd(res + 310 + (t >> 8), 1u); }
    if (bad) { const int hh = c >> 7, d_ = c & 127; atomicAdd(res + 128 + d_, 1u); atomicAdd(res + 256 + hh, 1u); }
}
__global__ void k_diag_init(unsigned* res) { if (threadIdx.x < 512) res[threadIdx.x] = (threadIdx.x == 1) ? 0xffffffffu : 0u; }
__device__ float diag_encode(unsigned v) {
    float x = (float)(v % 90u + 10u) * 100.0f; for (unsigned e = 0; e < v / 90u; ++e) x *= 10.0f; return x;
}
__global__ void k_diag_row0(const bf16* __restrict__ O2, const bf16* __restrict__ KV, unsigned* res) {
    if (threadIdx.x == 0) { unsigned best = 0, bestn = 0, n0 = 0;
        for (int k = 0; k < 256; ++k) { unsigned n = 0; for (int d = 0; d < 128; ++d) if (O2[OC_MLA + d] == KV[(size_t)k * 1024 + 128 + d]) ++n; if (k == 0) n0 = n; if (n > bestn) { bestn = n; best = k; } }
        res[400] = best; res[401] = bestn; res[402] = n0;
        for (int g = 0; g < 16; ++g) { unsigned bk = 999; for (int k = 0; k < 256 && bk == 999; ++k) { bool ok = true; for (int d = 0; d < 8; ++d) if (O2[OC_MLA + g * 8 + d] != KV[(size_t)k * 1024 + 128 + g * 8 + d]) ok = false; if (ok) bk = k; } res[410 + g] = bk; } }
}
__global__ void k_diag_encode(float* out, const unsigned* res, int mode) {
    unsigned v = 0;
    if (mode >= 120 && mode < 130) { out[0] += diag_encode(res[440 + mode - 120] > 2600u ? 2600u : res[440 + mode - 120]); return; }
    if (mode >= 100 && mode < 103) { out[0] += diag_encode(res[400 + mode - 100]); return; }
    if (mode >= 110 && mode < 120) { out[0] += diag_encode(res[410 + mode - 110]); return; }
    if (mode == 0) v = res[0] >> 6;
    else if (mode == 1) v = res[1] == 0xffffffffu ? 2699u : (res[1] & (SEQ - 1));
    else if (mode == 2) v = res[1] == 0xffffffffu ? 2699u : (res[1] >> 11);
    else if (mode == 3) { const float d = __builtin_bit_cast(float, res[2]); v = (unsigned)fminf(d * 100.0f, 2000.0f); }
    else if (mode == 4) { unsigned m = 0; for (int i = 0; i < 64; ++i) if (res[8 + i]) m |= 0; unsigned first = 99, last = 0, cnt = 0; for (int i = 0; i < 64; ++i) if (res[8 + i]) { if (first == 99) first = i; last = i; ++cnt; } v = cnt; }
    else if (mode == 5) { unsigned cnt = 0; for (int i = 0; i < 128; ++i) if (res[128 + i]) ++cnt; v = cnt; }
    else if (mode == 6) { unsigned m = 0; for (int i = 0; i < 4; ++i) if (res[256 + i]) m |= 1u << i; v = m; }
    else if (mode == 7) { unsigned first = 999; for (int i = 0; i < 128; ++i) if (res[128 + i]) { first = i; break; } v = first; }
    else if (mode == 8) { unsigned m = 0; for (int i = 0; i < 8; ++i) { unsigned any = 0; for (int j = 0; j < 8; ++j) any |= res[8 + ((i + 8 * j) & 63)]; if (any) m |= 1u << i; } v = m; }
    else if (mode == 9) { unsigned m = 0; for (int i = 0; i < 8; ++i) if (res[300 + i]) m |= 1u << i; v = m; }
    else if (mode == 10) { unsigned m = 0; for (int i = 0; i < 8; ++i) if (res[310 + i]) m |= 1u << i; v = m; }
    else if (mode == 11) { unsigned mx = 0, arg = 0; for (int i = 0; i < 8; ++i) if (res[310 + i] > mx) { mx = res[310 + i]; arg = i; } v = arg * 300 + (mx >> 3); }
    else if (mode >= 12 && mode < 20) v = res[310 + (mode - 12)];
    else if (mode >= 20 && mode < 84) v = res[8 + (mode - 20)];
    out[0] += diag_encode(v);
}

#endif

extern "C" void kernel_launch(void* const* d_in, const int* in_sizes, int n_in, void* d_out, int out_size, void* d_ws, size_t ws_size, hipStream_t stream) {
    static int grid = 0;
    if (grid == 0) {
        if (n_in != 21 || out_size != M * DM || ws_size < WS_END) { fprintf(stderr, "kernel_launch: unexpected shapes (n_in %d, out %d, ws %zu < %zu)\n", n_in, out_size, ws_size, (size_t)WS_END); grid = -1; return; }
        int dev = 0, cus = 0, per_cu = 0;
        if (hipGetDevice(&dev) != hipSuccess || hipDeviceGetAttribute(&cus, hipDeviceAttributeMultiprocessorCount, dev) != hipSuccess) { grid = -1; return; }
        if (hipFuncSetAttribute((const void*)mega_fwd, hipFuncAttributeMaxDynamicSharedMemorySize, LDS_BYTES) != hipSuccess) { fprintf(stderr, "kernel_launch: hipFuncSetAttribute failed\n"); grid = -1; return; }
        if (hipOccupancyMaxActiveBlocksPerMultiprocessor(&per_cu, (const void*)mega_fwd, NWAVES * 64, LDS_BYTES) != hipSuccess || per_cu < 1) fprintf(stderr, "kernel_launch: occupancy query reports %d\n", per_cu);
        (void)hipGetLastError();
        grid = cus;
    }
    if (grid < 0) return;
    (void)hipMemsetAsync((char*)d_ws + WS_CTL, 0, CTL_ZERO_BYTES, stream);
    Args a{};
    for (int i = 0; i < 21; ++i) a.in[i] = (const float*)d_in[i];
    a.out = (float*)d_out; a.ws = (unsigned char*)d_ws;
    int li = 0;
    auto persist = [&](int lo, int hi) { a.ph_lo = lo; a.ph_hi = hi; a.li = li++; hipLaunchKernelGGL(mega_fwd, dim3(grid), dim3(NWAVES * 64), LDS_BYTES, stream, a); };
#if NAIVE_MIX
    unsigned char* ws = (unsigned char*)d_ws;
    const bf16* P = (const bf16*)(ws + WS_P); const bf16* KV = (const bf16*)(ws + WS_KV); bf16* O = (bf16*)(ws + WS_O);
    float* XC = (float*)(ws + WS_MIXF); float* LA = XC + (size_t)M * 512; float* LB = LA + (size_t)M * 512;
    int lo = 0;
#if DIAG
    hipLaunchKernelGGL(k_diag_init, dim3(1), dim3(512), 0, stream, (unsigned*)(ws + WS_CTL + 256 * 1024));
#endif
    for (int L = 0; L < DEPTH; ++L) {
        persist(lo, L * 10 + 5);
#if !SB_OPT || DIAG
        hipLaunchKernelGGL(k_sb_naive, dim3(BATCH * 4 * 32), dim3(256), 0, stream, P, O);
#endif
#if !MLA_OPT || DIAG
        hipLaunchKernelGGL(k_mla_naive, dim3(BATCH * 4 * 32), dim3(256), 0, stream, P, KV, O);
#endif
#if !RET_OPT || DIAG
        hipLaunchKernelGGL(k_ret_naive, dim3(BATCH * 4 * 32), dim3(256), 0, stream, P, O);
#endif
#if !LRU_OPT || DIAG
        hipLaunchKernelGGL(k_lru_conv, dim3(M * 512 / 256), dim3(256), 0, stream, P, (const float*)d_in[6] + L * 4 * 512, (const float*)d_in[7] + L * 512, XC);
        hipLaunchKernelGGL(k_lru_gates, dim3(M * 512 / 256), dim3(256), 0, stream, (const float*)XC, (const float*)d_in[8] + (size_t)L * 4 * 128 * 128, (const float*)d_in[9] + L * 512,
                           (const float*)d_in[10] + (size_t)L * 4 * 128 * 128, (const float*)d_in[11] + L * 512, (const float*)d_in[12] + L * 512, LA, LB);
        hipLaunchKernelGGL(k_lru_scan, dim3(BATCH * 512 / 64), dim3(64), 0, stream, (const float*)LA, (const float*)LB, P, O);
#endif
#if DIAG
        if (L == 0) { unsigned* res = (unsigned*)(ws + WS_CTL + 256 * 1024);
            hipLaunchKernelGGL(k_diag, dim3(M), dim3(512), 0, stream, (const bf16*)O, (const bf16*)(ws + WS_MIXED), (int)DIAG_COL, 0.03f, res);
            hipLaunchKernelGGL(k_diag_row0, dim3(1), dim3(64), 0, stream, (const bf16*)(ws + WS_MIXED), KV, res); }
#endif
        lo = L * 10 + 5;
    }
    persist(lo, 41);
#if DIAG
    hipLaunchKernelGGL(k_diag_encode, dim3(1), dim3(1), 0, stream, (float*)d_out, (const unsigned*)(ws + WS_CTL + 256 * 1024), (int)DIAG_MODE);
#endif
#elif REPEAT_PHASE >= 0
    { int lo = 0; const int k = REPEAT_PHASE;
      for (int L = 0; L < DEPTH; ++L) { persist(lo, L * 10 + k + 1);
          if (k == 4) (void)hipMemsetAsync((char*)d_ws + WS_CTL + CW_Q * 4, 0, 16 * 64 * 4, stream);
          a.pad = (k == 6 || k == 9) ? 1 : 0; persist(L * 10 + k, L * 10 + k + 1); a.pad = 0; lo = L * 10 + k + 1; }
      persist(lo, 41); }
#else
    persist(0, 41);
#endif
}
```

```cpp
#include <hip/hip_runtime.h>
#include <cstdio>
#include <cstdint>

#ifndef SB_OPT
#define SB_OPT 1
#endif
#ifndef MLA_OPT
#define MLA_OPT 1
#endif
#ifndef REPEAT_PHASE
#define REPEAT_PHASE -1
#endif
#ifndef RET_OPT
#define RET_OPT 1
#endif
#ifndef LRU_OPT
#define LRU_OPT 1
#endif
#ifndef DIAG
#define DIAG 0
#endif
#ifndef DIAG_MODE
#define DIAG_MODE 124
#endif
#ifndef DIAG_UNIFORM
#define DIAG_UNIFORM 0
#endif
#ifndef NOSKIP
#define NOSKIP 0
#endif
#ifndef DIAG_COL
#define DIAG_COL OC_MLA
#endif
#ifndef NAIVE_MIX
#define NAIVE_MIX 0
#endif

#define LAS __attribute__((address_space(3)))
#define GAS __attribute__((address_space(1)))
typedef unsigned short bf16;
typedef short bf16x8 __attribute__((ext_vector_type(8)));
typedef float f32x4 __attribute__((ext_vector_type(4)));
typedef float f32x2 __attribute__((ext_vector_type(2)));
typedef unsigned u32x4 __attribute__((ext_vector_type(4)));
typedef unsigned u32x2 __attribute__((ext_vector_type(2)));
typedef GAS unsigned gu32;

constexpr int DM = 2048, BATCH = 8, SEQ = 2048, DEPTH = 4, M = BATCH * SEQ;
constexpr int NP = 6144;
constexpr int DFF = 5632, INW = 5952;
constexpr float EPS = 1e-6f;
constexpr float LOG2E = 1.4426950408889634f;
constexpr int PC_SBQ = 0, PC_SBK = 512, PC_SBV = 1024, PC_MQN = 1536, PC_MQP = 2048, PC_CKV = 2304, PC_KPE = 2816,
              PC_RQ = 3072, PC_RK = 3584, PC_RV = 4096, PC_RG = 4608, PC_LX = 5120, PC_LY = 5632, PC_GATE = 6144;
constexpr int OC_SB = 0, OC_MLA = 512, OC_RET = 1024, OC_LRU = 1536;

constexpr size_t MiB = 1u << 20;
constexpr size_t WS_CTL = 0, CTL_ZERO_BYTES = 1 * MiB;
constexpr size_t WS_WIN = 2 * MiB;
constexpr size_t WS_WUKV = 58 * MiB;
constexpr size_t WS_WBR = 59 * MiB;
constexpr size_t WS_WOUT = 67 * MiB;
constexpr size_t WS_WGU = 75 * MiB;
constexpr size_t WS_WDN = 119 * MiB;
constexpr size_t WS_WLRU = 141 * MiB;
constexpr size_t WS_ROPE = 142 * MiB;
constexpr size_t WS_H = 156 * MiB;
constexpr size_t WS_O = 220 * MiB;
constexpr size_t WS_MIXED = 284 * MiB;
constexpr size_t WS_KV = 348 * MiB;
constexpr size_t WS_MIXF = 380 * MiB;
constexpr size_t WS_P = 508 * MiB;
constexpr size_t WS_GT = 700 * MiB;
constexpr size_t WS_SSP = 956 * MiB;
constexpr size_t WS_X8 = 976 * MiB;
constexpr size_t WS_WG8 = 1008 * MiB;
constexpr size_t WS_END = 1024 * MiB;
constexpr int CW_TMO = 0, CW_Q = 1024, CW_BAR = 4096;
#define XCD_BAR_WORDS 3456
constexpr int MAX_LAUNCH = 16;
static_assert((CW_BAR + MAX_LAUNCH * XCD_BAR_WORDS) * 4 <= (int)CTL_ZERO_BYTES, "ctl");

constexpr int RING_OFF = 0, RING_BYTES = 131072;
constexpr int TBL_OFF = RING_BYTES;
constexpr int MISC_OFF = RING_BYTES + 4096;
constexpr int LDS_BYTES = 147456;
constexpr int NWAVES = 8;

#define LDS_WAIT() asm volatile("s_waitcnt lgkmcnt(0)" ::: "memory")
#define VM_WAIT() asm volatile("s_waitcnt vmcnt(0)" ::: "memory")
__device__ __forceinline__ unsigned f2bf(float f) { unsigned u = __builtin_bit_cast(unsigned, f); return (u + 0x7fffu + ((u >> 16) & 1u)) >> 16; }
__device__ __forceinline__ unsigned pk2(float lo, float hi) { return f2bf(lo) | (f2bf(hi) << 16); }
__device__ __forceinline__ float bf2f(unsigned short b) { return __builtin_bit_cast(float, ((unsigned)b) << 16); }
__device__ __forceinline__ float bflo(unsigned w) { return __builtin_bit_cast(float, w << 16); }
__device__ __forceinline__ float bfhi(unsigned w) { return __builtin_bit_cast(float, w & 0xffff0000u); }
typedef __bf16 bf16x2_t __attribute__((ext_vector_type(2)));
__device__ __forceinline__ unsigned cvt_pk_bf16(float lo, float hi) { const f32x2 v = {lo, hi}; const bf16x2_t b = __builtin_convertvector(v, bf16x2_t); return __builtin_bit_cast(unsigned, b); }
__device__ __forceinline__ unsigned pk4_fp8(float a, float b, float c, float d) { int r = 0; r = __builtin_amdgcn_cvt_pk_fp8_f32(a, b, r, false); r = __builtin_amdgcn_cvt_pk_fp8_f32(c, d, r, true); return (unsigned)r; }
constexpr float F8_WSCALE = 64.0f;
__device__ __forceinline__ float fast_exp2(float x) { return __builtin_amdgcn_exp2f(x); }
__device__ __forceinline__ float fast_log2(float x) { return __builtin_amdgcn_logf(x); }
__device__ __forceinline__ float fast_rcp(float x) { return __builtin_amdgcn_rcpf(x); }
__device__ __forceinline__ float sigmoidf_(float x) { return fast_rcp(1.0f + fast_exp2(-x * LOG2E)); }
__device__ __forceinline__ float siluf_(float x) { return x * sigmoidf_(x); }
__device__ __forceinline__ float gelu_tanh_(float x) { const float u = 0.7978845608028654f * (x + 0.044715f * x * x * x); return x * sigmoidf_(2.0f * u); }
__device__ __forceinline__ float lg2_gamma(int h) { return log2f(1.0f - exp2f(-5.0f - (float)h)); }

#define XB_TMO      128
#define XB_XCNT(j)  (256  + 64 * (j))
#define XB_XSUB(j)  (1280 + 64 * (j))
#define XB_XGEN(j)  (2304 + 64 * (j))
#define XB_TOP      3328
#define XB_TOPGEN   3392
#define XB_SPIN_CAP (1u << 21)
__device__ __forceinline__ unsigned xb_ld(unsigned* p)              { return __hip_atomic_load(p, __ATOMIC_RELAXED, __HIP_MEMORY_SCOPE_AGENT); }
__device__ __forceinline__ unsigned xb_add(unsigned* p, unsigned v) { return __hip_atomic_fetch_add(p, v, __ATOMIC_RELAXED, __HIP_MEMORY_SCOPE_AGENT); }
__device__ __forceinline__ unsigned xb_xcc_id() { return (unsigned)__builtin_amdgcn_s_getreg((3 << 11) | 20) & 0xFu; }
#define XB_SPIN(cond, bar) do { unsigned _sp = 0; while (cond) { __builtin_amdgcn_s_sleep(1); \
    if ((++_sp & 255u) == 0u) { if (xb_ld(&(bar)[XB_TMO])) break; if (_sp > XB_SPIN_CAP) { atomicAdd(&(bar)[XB_TMO], 1u); break; } } } } while (0)
struct XcdBarrier { unsigned* bar; unsigned x; volatile LAS unsigned* st; };
__device__ __forceinline__ XcdBarrier xcd_barrier_post(unsigned* bar, volatile LAS unsigned* st) {
    XcdBarrier b; b.bar = bar; b.x = xb_xcc_id(); b.st = st;
    if (threadIdx.x == 0) (void)xb_add(&bar[XB_XCNT(b.x)], 1u);
    return b;
}
__device__ __forceinline__ void xcd_barrier_complete(unsigned* bar, unsigned x, unsigned& nloc, unsigned& nx) {
    const unsigned G = gridDim.x * gridDim.y * gridDim.z;
    unsigned sum, cnt, mine, sp = 0u;
    for (;;) {
        sum = 0u; cnt = 0u; mine = 0u;
#pragma unroll
        for (unsigned j = 0; j < 16; ++j) { const unsigned c = xb_ld(&bar[XB_XCNT(j)]); sum += c; cnt += (c > 0u) ? 1u : 0u; mine = (j == x) ? c : mine; }
        if (sum == G) break;
        __builtin_amdgcn_s_sleep(1);
        if ((++sp & 255u) == 0u) { if (xb_ld(&bar[XB_TMO])) break; if (sp > XB_SPIN_CAP) { atomicAdd(&bar[XB_TMO], 1u); break; } }
    }
    nloc = mine > 0u ? mine : 1u; nx = cnt > 0u ? cnt : 1u;
}
__device__ __forceinline__ void xcd_barrier(const XcdBarrier& b) {
    asm volatile("s_waitcnt vmcnt(0)" ::: "memory");
    __syncthreads();
    if (threadIdx.x == 0) {
        unsigned* bar = b.bar;
        __builtin_amdgcn_s_waitcnt(0);
        unsigned nloc = b.st[0], nx = b.st[1];
        if (nloc == 0u) { xcd_barrier_complete(bar, b.x, nloc, nx); b.st[0] = nloc; b.st[1] = nx; }
        const unsigned old = xb_add(&bar[XB_XSUB(b.x)], 1u);
        const unsigned gen = old / nloc;
        if (old + 1u == (gen + 1u) * nloc) {
            __builtin_amdgcn_fence(__ATOMIC_RELEASE, "agent");
            asm volatile("s_waitcnt vmcnt(0)" ::: "memory");
            const unsigned og = xb_add(&bar[XB_TOP], 1u);
            const unsigned tg = og / nx;
            if (og + 1u == (tg + 1u) * nx) xb_add(&bar[XB_TOPGEN], 1u);
            else XB_SPIN(xb_ld(&bar[XB_TOPGEN]) == tg, bar);
            __builtin_amdgcn_fence(__ATOMIC_ACQUIRE, "agent");
            xb_add(&bar[XB_XGEN(b.x)], 1u);
            asm volatile("s_waitcnt vmcnt(0)" ::: "memory");
        } else {
            XB_SPIN(xb_ld(&bar[XB_XGEN(b.x)]) == gen, bar);
            __builtin_amdgcn_fence(__ATOMIC_ACQUIRE, "agent");
            asm volatile("s_waitcnt vmcnt(0)" ::: "memory");
        }
    }
    __syncthreads();
}

namespace pg8 {
constexpr int BM = 256, BK = 64, HALF = 128, HTB = HALF * BK * 2, STAGE_BYTES = 8 * HTB, NXCD = 8, WGM = 8;
__host__ __device__ __forceinline__ int lds_byte(int r, int c) { const int st = (r >> 4) * 2 + (c >> 5), rr = r & 15, cc = c & 31, ob = rr * 64 + cc * 2; return st * 1024 + (ob ^ (((ob >> 9) & 1) << 5)); }
__host__ __device__ __forceinline__ void stage_rc(int b, int& R, int& C) { const int st = b / 1024, sb = b % 1024, swz = sb ^ (((sb >> 9) & 1) << 5); R = (st >> 1) * 16 + swz / 64; C = (st & 1) * 32 + (swz % 64) / 2; }
__host__ __device__ __forceinline__ int perm32(int rho) { const int n = rho >> 4, i = rho & 15; return 8 * (i >> 2) + 4 * n + (i & 3); }
struct Unit { int pm, pn, sub; };
struct Gemm { const bf16* A; const bf16* Bt; int M, N, K, lda, ldb; size_t subA, subB; };
struct StaticOrder {
    int nM, nN, nwg, G, c;
    __host__ __device__ void init(int M_, int N_, int G_, int c_) { nM = M_ / BM; nN = N_ / BM; nwg = nM * nN; G = G_; c = c_; }
    __host__ __device__ bool next(int i, Unit& u) const {
        const long L = (long)i * G + c; if (L >= nwg) return false;
        int wgid = (int)L; { const int q = nwg / NXCD, r = nwg % NXCD, xcd = wgid % NXCD, off = wgid / NXCD; wgid = (xcd < r ? xcd * (q + 1) : r * (q + 1) + (xcd - r) * q) + off; }
        const int nig = WGM * nN, gid = wgid / nig, fm = gid * WGM, gsz = (nM - fm) < WGM ? (nM - fm) : WGM;
        u.pm = fm + ((wgid % nig) % gsz); u.pn = (wgid % nig) / gsz; u.sub = 0; return true;
    }
};
struct PairOrder { StaticOrder base;
    __host__ __device__ bool next(int i, Unit& u) const { if (!base.next(i >> 1, u)) return false; u.pn = 2 * u.pn + (i & 1); return true; } };
template <class B> struct RangeOrder { B base; int lo, hi;
    __host__ __device__ bool next(int i, Unit& u) const { return (lo + i < hi) && base.next(lo + i, u); } };
struct MergeOrder { StaticOrder base;
    __host__ __device__ bool next(int i, Unit& u) const { if (!base.next(i >> 2, u)) return false; u.sub = i & 3; return true; } };
typedef int v8i32 __attribute__((ext_vector_type(8)));
__device__ __forceinline__ v8i32 frag8(const bf16x8 lo, const bf16x8 hi) { const u32x4 a = __builtin_bit_cast(u32x4, lo), b = __builtin_bit_cast(u32x4, hi); return (v8i32){(int)a.x, (int)a.y, (int)a.z, (int)a.w, (int)b.x, (int)b.y, (int)b.z, (int)b.w}; }
template <class Epi, bool ALIGN_EPI = true, bool SP2 = true, class Sched = StaticOrder, bool F8 = false>
__device__ __forceinline__ void gemm_phase(LAS unsigned char* lds, const Gemm g, const Sched& S, const Epi& E, int tid_) {
    asm volatile("" : "+v"(tid_));
    const int tid = tid_, wid = __builtin_amdgcn_readfirstlane(tid >> 6), lane = tid & 63, wr = wid >> 2, wc = wid & 3, fr = lane & 15, fq = lane >> 4;
    const int K = g.K, nt = K / BK;
    unsigned voffA[2], voffB[2];
#pragma unroll
    for (int i = 0; i < 2; ++i) { int R, C; stage_rc(tid * 16 + i * 8192, R, C); const int Rb = Epi::PERM ? ((R & ~31) + perm32(R & 31)) : R;
        voffA[i] = (unsigned)(R * g.lda + C) * 2u; voffB[i] = (unsigned)(Rb * g.ldb + C) * 2u; }
    const size_t kstep = (size_t)(BK * 2);
    const size_t hstepA = (size_t)HALF * g.lda * 2, hstepB = (size_t)HALF * g.ldb * 2;
    const size_t tstepA = 2 * hstepA, tstepB = 2 * hstepB;
    const unsigned ldsw = (unsigned)wid * 1024u;
    const int aoff = lds_byte(wr * 64 + fr, fq * 8), boff = lds_byte(wc * 32 + fr, fq * 8);
#define PG8_SA(b, h) (((b) * 2 + (h)) * HTB)
#define PG8_SB(b, h) ((4 + (b) * 2 + (h)) * HTB)
#define PG8_STAGE(bufoff, gbase, voff) do { _Pragma("unroll") for (int _i = 0; _i < 2; ++_i) \
        __builtin_amdgcn_global_load_lds((const unsigned*)((const char*)(gbase) + (voff)[_i]), (LAS unsigned*)(lds + (bufoff) + ldsw + _i * 8192), 16, 0, 0); } while (0)
#define PG8_LDA(dst, b, h) do { _Pragma("unroll") for (int m = 0; m < 4; ++m) { if constexpr (F8) { const u32x4 lo_ = *(const LAS u32x4*)(lds + PG8_SA(b, h) + aoff + m * 2048), hi_ = *(const LAS u32x4*)(lds + PG8_SA(b, h) + aoff + 1024 + m * 2048); \
            dst##8[m] = (v8i32){(int)lo_.x, (int)lo_.y, (int)lo_.z, (int)lo_.w, (int)hi_.x, (int)hi_.y, (int)hi_.z, (int)hi_.w}; } \
        else { _Pragma("unroll") for (int k = 0; k < 2; ++k) dst[m][k] = *(const LAS bf16x8*)(lds + PG8_SA(b, h) + aoff + m * 2048 + k * 1024); } } } while (0)
#define PG8_LDB(dst, b, h) do { _Pragma("unroll") for (int n = 0; n < 2; ++n) { if constexpr (F8) { const u32x4 lo_ = *(const LAS u32x4*)(lds + PG8_SB(b, h) + boff + n * 2048), hi_ = *(const LAS u32x4*)(lds + PG8_SB(b, h) + boff + 1024 + n * 2048); \
            dst##8[n] = (v8i32){(int)lo_.x, (int)lo_.y, (int)lo_.z, (int)lo_.w, (int)hi_.x, (int)hi_.y, (int)hi_.z, (int)hi_.w}; } \
        else { _Pragma("unroll") for (int k = 0; k < 2; ++k) dst[n][k] = *(const LAS bf16x8*)(lds + PG8_SB(b, h) + boff + n * 2048 + k * 1024); } } } while (0)
#define PG8_MMA(ai, bj, At, Bt) do { __builtin_amdgcn_s_setprio(1); _Pragma("unroll") for (int m = 0; m < 4; ++m) _Pragma("unroll") for (int n = 0; n < 2; ++n) { \
        if constexpr (F8) asm volatile("v_mfma_scale_f32_16x16x128_f8f6f4 %0, %1, %2, %0, %3, %3 op_sel_hi:[0,0,0]" : "+v"(acc[ai][bj][m][n]) : "v"(Bt##8[n]), "v"(At##8[m]), "v"(sc1));   \
        else { _Pragma("unroll") for (int k = 0; k < 2; ++k) acc[ai][bj][m][n] = __builtin_amdgcn_mfma_f32_16x16x32_bf16(Bt[n][k], At[m][k], acc[ai][bj][m][n], 0, 0, 0); } } __builtin_amdgcn_s_setprio(0); } while (0)
#define PG8_WAIT_V(n) asm volatile("s_waitcnt vmcnt(" #n ")" ::: "memory")
#define PG8_WAIT_L(n) asm volatile("s_waitcnt lgkmcnt(" #n ")" ::: "memory")
#define PG8_BAR __builtin_amdgcn_s_barrier()
#define PG8_SCHED __builtin_amdgcn_sched_barrier(0)
    Unit cur, nxt; int ui = 0;
    if (!S.next(0, cur)) return;
    f32x4 acc[2][2][4][2];
#pragma unroll
    for (int a = 0; a < 2; ++a)
#pragma unroll
        for (int b = 0; b < 2; ++b)
#pragma unroll
            for (int m = 0; m < 4; ++m)
#pragma unroll
                for (int n = 0; n < 2; ++n) acc[a][b][m][n] = (f32x4){0.f, 0.f, 0.f, 0.f};
    bf16x8 At[4][2], B0[2][2], B1[2][2]; v8i32 At8[4], B08[2], B18[2];
    int sc1 = 0x7F7F7F7F; if constexpr (F8) asm volatile("" : "+v"(sc1));
    const char* cA = (const char*)g.A + (size_t)cur.pm * tstepA + (size_t)cur.sub * g.subA; const char* cB = (const char*)g.Bt + (size_t)cur.pn * tstepB + (size_t)cur.sub * g.subB;
    if constexpr (SP2) {
        PG8_STAGE(PG8_SB(0, 0), cB, voffB); PG8_STAGE(PG8_SB(0, 1), cB + hstepB, voffB); PG8_STAGE(PG8_SA(0, 0), cA, voffA); PG8_STAGE(PG8_SA(0, 1), cA + hstepA, voffA);
        if (wr == 1) PG8_BAR;
        PG8_WAIT_V(2); PG8_BAR;
        PG8_STAGE(PG8_SB(1, 0), cB + kstep, voffB); PG8_STAGE(PG8_SA(1, 0), cA + kstep, voffA); PG8_STAGE(PG8_SB(1, 1), cB + hstepB + kstep, voffB);
        PG8_WAIT_V(6); PG8_BAR;
    } else {
        PG8_STAGE(PG8_SB(0, 0), cB, voffB); PG8_STAGE(PG8_SA(0, 0), cA, voffA); PG8_STAGE(PG8_SB(0, 1), cB + hstepB, voffB); PG8_STAGE(PG8_SA(0, 1), cA + hstepA, voffA);
        if (wr == 1) PG8_BAR;
        PG8_WAIT_V(4); PG8_BAR;
        PG8_STAGE(PG8_SB(1, 0), cB + kstep, voffB); PG8_STAGE(PG8_SA(1, 0), cA + kstep, voffA); PG8_STAGE(PG8_SB(1, 1), cB + hstepB + kstep, voffB);
        PG8_WAIT_V(6); PG8_BAR;
    }
    for (;;) {
        const bool has_next = S.next(ui + 1, nxt);
        const char* nA = has_next ? (const char*)g.A + (size_t)nxt.pm * tstepA + (size_t)nxt.sub * g.subA : cA; const char* nB = has_next ? (const char*)g.Bt + (size_t)nxt.pn * tstepB + (size_t)nxt.sub * g.subB : cB;
        for (int t = 0; t < nt; t += 2) {
            const bool last = (t == nt - 2);
            const char* a1 = cA + (size_t)(t + 1) * kstep;
            const char* a2 = last ? nA : cA + (size_t)(t + 2) * kstep; const char* b2 = last ? nB : cB + (size_t)(t + 2) * kstep;
            const char* a3 = a2 + kstep; const char* b3 = b2 + kstep;
            if constexpr (SP2) {
            PG8_LDB(B0, 0, 0); PG8_LDB(B1, 0, 1); PG8_SCHED; PG8_LDA(At, 0, 0); PG8_STAGE(PG8_SA(1, 1), a1 + hstepA, voffA);
            PG8_WAIT_V(8); PG8_WAIT_L(0); PG8_BAR; PG8_MMA(0, 0, At, B0); PG8_MMA(0, 1, At, B1); PG8_BAR; PG8_SCHED;
            PG8_LDA(At, 0, 1); PG8_STAGE(PG8_SB(0, 0), b2, voffB); PG8_STAGE(PG8_SB(0, 1), b2 + hstepB, voffB); PG8_STAGE(PG8_SA(0, 0), a2, voffA);
            PG8_WAIT_V(8); PG8_WAIT_L(0); PG8_BAR; PG8_MMA(1, 0, At, B0); PG8_MMA(1, 1, At, B1); PG8_BAR; PG8_SCHED;
            PG8_LDB(B0, 1, 0); PG8_LDB(B1, 1, 1); PG8_SCHED; PG8_LDA(At, 1, 0); PG8_STAGE(PG8_SA(0, 1), a2 + hstepA, voffA);
            PG8_WAIT_V(8); PG8_WAIT_L(0); PG8_BAR; PG8_MMA(0, 0, At, B0); PG8_MMA(0, 1, At, B1); PG8_BAR; PG8_SCHED;
            PG8_LDA(At, 1, 1); PG8_STAGE(PG8_SB(1, 0), b3, voffB); PG8_STAGE(PG8_SB(1, 1), b3 + hstepB, voffB); PG8_STAGE(PG8_SA(1, 0), a3, voffA);
            PG8_WAIT_V(8); PG8_WAIT_L(0); PG8_BAR; PG8_MMA(1, 0, At, B0); PG8_MMA(1, 1, At, B1); PG8_BAR; PG8_SCHED;
            } else {
            PG8_LDB(B0, 0, 0); PG8_SCHED; PG8_LDA(At, 0, 0); PG8_STAGE(PG8_SA(1, 1), a1 + hstepA, voffA);
            PG8_WAIT_L(8); PG8_BAR; PG8_WAIT_L(0); PG8_MMA(0, 0, At, B0); PG8_BAR; PG8_SCHED;
            PG8_LDB(B1, 0, 1); PG8_STAGE(PG8_SB(0, 0), b2, voffB);
            PG8_BAR; PG8_WAIT_L(0); PG8_MMA(0, 1, At, B1); PG8_BAR;
            PG8_LDA(At, 0, 1); PG8_STAGE(PG8_SA(0, 0), a2, voffA);
            PG8_BAR; PG8_WAIT_L(0); PG8_MMA(1, 0, At, B0); PG8_BAR; PG8_SCHED;
            PG8_STAGE(PG8_SB(0, 1), b2 + hstepB, voffB);
            PG8_WAIT_V(6); PG8_BAR; PG8_MMA(1, 1, At, B1); PG8_BAR;
            PG8_LDB(B0, 1, 0); PG8_SCHED; PG8_LDA(At, 1, 0); PG8_STAGE(PG8_SA(0, 1), a2 + hstepA, voffA);
            PG8_WAIT_L(8); PG8_BAR; PG8_WAIT_L(0); PG8_MMA(0, 0, At, B0); PG8_BAR; PG8_SCHED;
            PG8_LDB(B1, 1, 1); PG8_STAGE(PG8_SB(1, 0), b3, voffB);
            PG8_BAR; PG8_WAIT_L(0); PG8_MMA(0, 1, At, B1); PG8_BAR;
            PG8_LDA(At, 1, 1); PG8_STAGE(PG8_SA(1, 0), a3, voffA);
            PG8_BAR; PG8_WAIT_L(0); PG8_MMA(1, 0, At, B0); PG8_BAR; PG8_SCHED;
            PG8_STAGE(PG8_SB(1, 1), b3 + hstepB, voffB);
            PG8_WAIT_V(6); PG8_BAR; PG8_MMA(1, 1, At, B1); PG8_BAR;
            }
        }
        if constexpr (ALIGN_EPI) { if (wr == 0) PG8_BAR; }
        if constexpr (F8) asm volatile("s_nop 15\n\ts_nop 15" ::: "memory");
        { int z_ = 0; asm volatile("" : "+v"(z_)); const int ln_ = (int)__builtin_amdgcn_mbcnt_hi(~0u, __builtin_amdgcn_mbcnt_lo(~0u, (unsigned)z_));
          E(acc, cur, ui, wr, wc, ln_ & 15, ln_ >> 4); }
        if (!has_next) break;
        if (Epi::zero_after(cur)) {
#pragma unroll
        for (int a = 0; a < 2; ++a)
#pragma unroll
            for (int b = 0; b < 2; ++b)
#pragma unroll
                for (int m = 0; m < 4; ++m)
#pragma unroll
                    for (int n = 0; n < 2; ++n) acc[a][b][m][n] = (f32x4){0.f, 0.f, 0.f, 0.f}; }
        cur = nxt; cA = nA; cB = nB; ++ui;
        if constexpr (ALIGN_EPI) { if (wr == 1) PG8_BAR; }
    }
    PG8_WAIT_V(0);
    if constexpr (!ALIGN_EPI) { if (wr == 0) PG8_BAR; }
    PG8_BAR;
#undef PG8_SA
#undef PG8_SB
#undef PG8_STAGE
#undef PG8_LDA
#undef PG8_LDB
#undef PG8_MMA
#undef PG8_WAIT_V
#undef PG8_WAIT_L
#undef PG8_BAR
#undef PG8_SCHED
}
}
using pg8::Unit;

typedef f32x4 (&AccRef)[2][2][4][2];
__device__ __forceinline__ u32x4 pack8(f32x4 v0, f32x4 v1) { u32x4 w; w.x = cvt_pk_bf16(v0[0], v0[1]); w.y = cvt_pk_bf16(v0[2], v0[3]); w.z = cvt_pk_bf16(v1[0], v1[1]); w.w = cvt_pk_bf16(v1[2], v1[3]); return w; }

struct RmsTab { const LAS float* tbl; int tag[4]; };
__device__ __forceinline__ void scale_rows_rms(AccRef acc, const RmsTab& T, int pm, int lr0, float pre = 1.0f) {
    const int slot = (pm == T.tag[0]) ? 0 : (pm == T.tag[1]) ? 1 : (pm == T.tag[2]) ? 2 : 3;
#pragma unroll
    for (int ai = 0; ai < 2; ++ai)
#pragma unroll
        for (int m = 0; m < 4; ++m) { const float rs = T.tbl[slot * 256 + lr0 + ai * 128 + m * 16] * pre;
#pragma unroll
            for (int bj = 0; bj < 2; ++bj) { acc[ai][bj][m][0] *= rs; acc[ai][bj][m][1] *= rs; } }
}
struct EpiInProj {
    static constexpr bool PERM = true; static __device__ __forceinline__ bool zero_after(const Unit&) { return true; }
    bf16* P; const float* c32; const float* s32; const float* c64; const float* s64; RmsTab T; int toff; float pre; float* css; const int* pos;
    __device__ __forceinline__ void operator()(AccRef acc, const Unit& u, int, int wr, int wc, int fr, int fq) const {
        const int t = u.pn + toff; const int row0 = u.pm * 256 + wr * 64 + fr; const int ch0 = wc * 32 + 8 * fq;
        scale_rows_rms(acc, T, u.pm, wr * 64 + fr, pre);
        bf16* base = P + (size_t)t * 256 + ch0;
        const bool rope = (t == 8) | (t == 11) | ((t >= 12) & (t < 16));
        if (!rope) {
            const int act = ((t == 18) | (t == 19)) ? 2 : ((t == 22) | (t == 23)) ? 3 : 0;
#pragma unroll
            for (int ai = 0; ai < 2; ++ai)
#pragma unroll
                for (int m = 0; m < 4; ++m) { bf16* rowp = base + (size_t)(row0 + ai * 128 + m * 16) * NP; float part = 0.f;
#pragma unroll
                    for (int bj = 0; bj < 2; ++bj) { f32x4 v0 = acc[ai][bj][m][0], v1 = acc[ai][bj][m][1];
                        part += (v0[0] * v0[0] + v0[1] * v0[1]) + (v0[2] * v0[2] + v0[3] * v0[3]) + (v1[0] * v1[0] + v1[1] * v1[1]) + (v1[2] * v1[2] + v1[3] * v1[3]);
                        if (act == 1) {
#pragma unroll
                            for (int j = 0; j < 4; ++j) { v0[j] = sigmoidf_(v0[j]); v1[j] = sigmoidf_(v1[j]); } }
                        else if (act == 2) {
#pragma unroll
                            for (int j = 0; j < 4; ++j) { v0[j] = siluf_(v0[j]); v1[j] = siluf_(v1[j]); } }
                        else if (act == 3) {
#pragma unroll
                            for (int j = 0; j < 4; ++j) { v0[j] = gelu_tanh_(v0[j]); v1[j] = gelu_tanh_(v1[j]); } }
                        *(u32x4*)(rowp + bj * 128) = pack8(v0, v1); }
                    if ((t == 9) | (t == 10)) { const int lane = fq * 16 + fr;
                        part += __builtin_bit_cast(float, __builtin_amdgcn_ds_bpermute((lane ^ 16) << 2, __builtin_bit_cast(int, part)));
                        part += __builtin_bit_cast(float, __builtin_amdgcn_ds_bpermute((lane ^ 32) << 2, __builtin_bit_cast(int, part)));
                        if (fq == 0) css[(size_t)(row0 + ai * 128 + m * 16) * 8 + (t - 9) * 4 + wc] = part; } }
        } else {
            const bool r64 = (t >= 12);
            const int nf = r64 ? 64 : 32;
            const int f0 = ch0 & (nf - 1);
            float frv[8];
#pragma unroll
            for (int j = 0; j < 8; ++j) frv[j] = fast_exp2((-13.287712379549449f / (float)nf) * (float)(f0 + j)) * 0.15915494309189535f;
            float lg = 0.f;
            if (r64) { const int hd = ((t - 12) & 1) * 2 + (ch0 >> 6); lg = lg2_gamma(hd) * ((t >= 14) ? -1.f : 1.f); }
#pragma unroll
            for (int ai = 0; ai < 2; ++ai)
#pragma unroll
                for (int m = 0; m < 4; ++m) { const int row = row0 + ai * 128 + m * 16; bf16* rowp = base + (size_t)row * NP;
                    const float fac = r64 ? fast_exp2(lg * (float)(row & 127)) : 1.f;
                    const float pf = (float)pos[row]; f32x4 ca, cb, sa, sb;
#pragma unroll
                    for (int j = 0; j < 4; ++j) { const float ta = __builtin_amdgcn_fractf(pf * frv[j]), tb = __builtin_amdgcn_fractf(pf * frv[4 + j]);
                        ca[j] = __builtin_amdgcn_cosf(ta); sa[j] = __builtin_amdgcn_sinf(ta); cb[j] = __builtin_amdgcn_cosf(tb); sb[j] = __builtin_amdgcn_sinf(tb); }
                    const f32x4 x1a = acc[ai][0][m][0], x1b = acc[ai][0][m][1], x2a = acc[ai][1][m][0], x2b = acc[ai][1][m][1];
                    f32x4 y1a, y1b, y2a, y2b;
#pragma unroll
                    for (int j = 0; j < 4; ++j) { y1a[j] = (x1a[j] * ca[j] - x2a[j] * sa[j]) * fac; y2a[j] = (x2a[j] * ca[j] + x1a[j] * sa[j]) * fac;
                                                  y1b[j] = (x1b[j] * cb[j] - x2b[j] * sb[j]) * fac; y2b[j] = (x2b[j] * cb[j] + x1b[j] * sb[j]) * fac; }
                    *(u32x4*)(rowp) = pack8(y1a, y1b); *(u32x4*)(rowp + 128) = pack8(y2a, y2b); }
        }
    }
};
struct EpiGate {
    static constexpr bool PERM = true; static __device__ __forceinline__ bool zero_after(const Unit&) { return true; }
    bf16* GT; RmsTab T; float pre;
    __device__ __forceinline__ void operator()(AccRef acc, const Unit& u, int, int wr, int wc, int fr, int fq) const {
        scale_rows_rms(acc, T, u.pm, wr * 64 + fr, pre);
        const int q = u.pn & 3, wcp = 2 * (q & 1) + (wc >> 1), fqp = 2 * (wc & 1) + (fq >> 1);
        bf16* base = GT + (size_t)((u.pm * 8 + (u.pn >> 2)) * 4) * 65536 + (size_t)((q >> 1) * 8) * 4096 + ((wr * 4 + wcp) * 64 + fqp * 16 + fr) * 8 + (fq & 1) * 4;
#pragma unroll
        for (int ai = 0; ai < 2; ++ai)
#pragma unroll
            for (int m = 0; m < 4; ++m) { bf16* sp = base + (ai * 4 + m) * 4096;
                f32x4 u0, v1, u2, g3;
#pragma unroll
                for (int i = 0; i < 4; ++i) {
                    const float d0 = 1.0f + fminf(fast_exp2(-acc[ai][0][m][0][i]), 1e30f), d1 = 1.0f + fminf(fast_exp2(-acc[ai][0][m][1][i]), 1e30f);
                    const float d2 = 1.0f + fminf(fast_exp2(-acc[ai][1][m][0][i]), 1e30f), d3 = 1.0f + fminf(fast_exp2(-acc[ai][1][m][1][i]), 1e30f);
                    u0[i] = d1 * fast_rcp(d0); v1[i] = d2 * fast_rcp(d1); u2[i] = d3 * fast_rcp(d2); g3[i] = fast_rcp(d3); }
                u32x2 w;
                w.x = cvt_pk_bf16(u0[0], u0[1]); w.y = cvt_pk_bf16(u0[2], u0[3]); *(u32x2*)(sp) = w;
                w.x = cvt_pk_bf16(v1[0], v1[1]); w.y = cvt_pk_bf16(v1[2], v1[3]); *(u32x2*)(sp + 65536) = w;
                w.x = cvt_pk_bf16(u2[0], u2[1]); w.y = cvt_pk_bf16(u2[2], u2[3]); *(u32x2*)(sp + 2 * 65536) = w;
                w.x = cvt_pk_bf16(g3[0], g3[1]); w.y = cvt_pk_bf16(g3[2], g3[3]); *(u32x2*)(sp + 3 * 65536) = w; }
    }
};
struct EpiKV {
    static constexpr bool PERM = true; static __device__ __forceinline__ bool zero_after(const Unit&) { return true; }
    bf16* KV; const LAS float* tbl;
    __device__ __forceinline__ void operator()(AccRef acc, const Unit& u, int ui, int wr, int wc, int fr, int fq) const {
        const int lr0 = wr * 64 + fr; const int col0 = u.pn * 256 + wc * 32 + 8 * fq;
#pragma unroll
        for (int ai = 0; ai < 2; ++ai)
#pragma unroll
            for (int m = 0; m < 4; ++m) { const int lr = lr0 + ai * 128 + m * 16; const float rs = tbl[(ui & 3) * 256 + lr]; bf16* rowp = KV + (size_t)(u.pm * 256 + lr) * 1024 + col0;
#pragma unroll
                for (int bj = 0; bj < 2; ++bj) *(u32x4*)(rowp + bj * 128) = pack8(acc[ai][bj][m][0] * rs, acc[ai][bj][m][1] * rs); }
    }
};
struct EpiMergeH {
    static constexpr bool PERM = true; static __device__ __forceinline__ bool zero_after(const Unit& u) { return u.sub == 3; }
    const bf16* G; bf16* mixed;
    static __device__ __forceinline__ void ld8(const bf16* p, f32x4& a, f32x4& b) { const u32x4 w = *(const u32x4*)p; a = (f32x4){bflo(w.x), bfhi(w.x), bflo(w.y), bfhi(w.y)}; b = (f32x4){bflo(w.z), bfhi(w.z), bflo(w.w), bfhi(w.w)}; }
    __device__ __forceinline__ void operator()(AccRef acc, const Unit& u, int, int wr, int wc, int fr, int fq) const {
        const int row0 = u.pm * 256 + wr * 64 + fr; const int ch0 = wc * 32 + 8 * fq; const int sub = u.sub; const int tid8 = ((wr * 4 + wc) * 64 + fq * 16 + fr) * 8;
        const bf16* g0 = G + (size_t)((u.pm * 8 + u.pn) * 4 + sub) * 65536 + tid8;
        u32x4 w[2][4][2];
#pragma unroll
        for (int ai = 0; ai < 2; ++ai)
#pragma unroll
            for (int m = 0; m < 4; ++m)
#pragma unroll
                for (int bj = 0; bj < 2; ++bj) w[ai][m][bj] = *(const u32x4*)(g0 + (bj * 8 + ai * 4 + m) * 4096);
#pragma unroll
        for (int ai = 0; ai < 2; ++ai)
#pragma unroll
            for (int m = 0; m < 4; ++m)
#pragma unroll
                for (int bj = 0; bj < 2; ++bj) { const u32x4 q = w[ai][m][bj];
                    acc[ai][bj][m][0] *= (f32x4){bflo(q.x), bfhi(q.x), bflo(q.y), bfhi(q.y)}; acc[ai][bj][m][1] *= (f32x4){bflo(q.z), bfhi(q.z), bflo(q.w), bfhi(q.w)}; }
        if (sub == 3) {
#pragma unroll
            for (int ai = 0; ai < 2; ++ai)
#pragma unroll
                for (int m = 0; m < 4; ++m) { const size_t row = (size_t)(row0 + ai * 128 + m * 16);
#pragma unroll
                    for (int bj = 0; bj < 2; ++bj) *(u32x4*)(mixed + row * DM + u.pn * 256 + bj * 128 + ch0) = pack8(acc[ai][bj][m][0], acc[ai][bj][m][1]); } }
    }
};
template <bool EARLY> struct EpiResidT {
    static constexpr bool PERM = true; static __device__ __forceinline__ bool zero_after(const Unit&) { return true; }
    bf16* X; float* SSout; unsigned char* X8;
    __device__ __forceinline__ void operator()(AccRef acc, const Unit& u, int, int wr, int wc, int fr, int fq) const {
        const int row0 = u.pm * 256 + wr * 64 + fr, col0 = u.pn * 256 + wc * 32 + 8 * fq; const int lane = fq * 16 + fr;
        u32x4 wx[4][2];
        auto ld_half = [&](int ai) {
#pragma unroll
            for (int m = 0; m < 4; ++m)
#pragma unroll
                for (int bj = 0; bj < 2; ++bj) wx[m][bj] = *(const u32x4*)(X + (size_t)(row0 + ai * 128 + m * 16) * DM + col0 + bj * 128); };
        auto add_half = [&](int ai) {
#pragma unroll
            for (int m = 0; m < 4; ++m)
#pragma unroll
                for (int bj = 0; bj < 2; ++bj) { const u32x4 w = wx[m][bj];
                    acc[ai][bj][m][0] += (f32x4){bflo(w.x), bfhi(w.x), bflo(w.y), bfhi(w.y)}; acc[ai][bj][m][1] += (f32x4){bflo(w.z), bfhi(w.z), bflo(w.w), bfhi(w.w)}; } };
        auto st_half = [&](int ai) {
#pragma unroll
            for (int m = 0; m < 4; ++m) { const int row = row0 + ai * 128 + m * 16; float part = 0.f;
#pragma unroll
                for (int bj = 0; bj < 2; ++bj) { bf16* p = X + (size_t)row * DM + col0 + bj * 128; const f32x4 v0 = acc[ai][bj][m][0], v1 = acc[ai][bj][m][1];
                    part += (v0[0] * v0[0] + v0[1] * v0[1]) + (v0[2] * v0[2] + v0[3] * v0[3]) + (v1[0] * v1[0] + v1[1] * v1[1]) + (v1[2] * v1[2] + v1[3] * v1[3]);
                    *(u32x4*)p = pack8(v0, v1);
                    if (X8) { u32x2 q; q.x = pk4_fp8(v0[0], v0[1], v0[2], v0[3]); q.y = pk4_fp8(v1[0], v1[1], v1[2], v1[3]); *(u32x2*)(X8 + (size_t)row * DM + col0 + bj * 128) = q; } }
                part += __builtin_bit_cast(float, __builtin_amdgcn_ds_bpermute((lane ^ 16) << 2, __builtin_bit_cast(int, part)));
                part += __builtin_bit_cast(float, __builtin_amdgcn_ds_bpermute((lane ^ 32) << 2, __builtin_bit_cast(int, part)));
                if (fq == 0) SSout[(size_t)row * 32 + u.pn * 4 + wc] = part; } };
        if constexpr (EARLY) {
            u32x4 wy[4][2];
#pragma unroll
            for (int m = 0; m < 4; ++m)
#pragma unroll
                for (int bj = 0; bj < 2; ++bj) wy[m][bj] = *(const u32x4*)(X + (size_t)(row0 + 128 + m * 16) * DM + col0 + bj * 128);
            ld_half(0); __builtin_amdgcn_sched_barrier(0);
            add_half(0); st_half(0);
#pragma unroll
            for (int m = 0; m < 4; ++m)
#pragma unroll
                for (int bj = 0; bj < 2; ++bj) wx[m][bj] = wy[m][bj];
            add_half(1); st_half(1);
        } else { ld_half(0); add_half(0); st_half(0); ld_half(1); add_half(1); st_half(1); }
    }
};
typedef EpiResidT<false> EpiResid;
struct EpiSwiGLU {
    static constexpr bool PERM = true; static __device__ __forceinline__ bool zero_after(const Unit&) { return true; }
    bf16* HB; RmsTab T;
    __device__ __forceinline__ void operator()(AccRef acc, const Unit& u, int, int wr, int wc, int fr, int fq) const {
        const int row0 = u.pm * 256 + wr * 64 + fr; const int col0 = u.pn * 128 + wc * 32 + 8 * fq;
        scale_rows_rms(acc, T, u.pm, wr * 64 + fr);
#pragma unroll
        for (int ai = 0; ai < 2; ++ai)
#pragma unroll
            for (int m = 0; m < 4; ++m) { bf16* rowp = HB + (size_t)(row0 + ai * 128 + m * 16) * DFF + col0;
                f32x4 v0, v1;
#pragma unroll
                for (int j = 0; j < 4; ++j) { v0[j] = siluf_(acc[ai][0][m][0][j]) * acc[ai][1][m][0][j]; v1[j] = siluf_(acc[ai][0][m][1][j]) * acc[ai][1][m][1][j]; }
                *(u32x4*)rowp = pack8(v0, v1); }
    }
};


typedef float f32x16 __attribute__((ext_vector_type(16)));
typedef short s16x4 __attribute__((ext_vector_type(4)));
typedef LAS const unsigned char* lds_cptr;
__device__ __forceinline__ s16x4 vtr(lds_cptr p) { return __builtin_bit_cast(s16x4, __builtin_amdgcn_ds_read_tr16_b64_v4i16((LAS s16x4*)p)); }
__device__ __forceinline__ void pair_swap(float x, float& lo, float& hi) { auto rr = __builtin_amdgcn_permlane32_swap(__builtin_bit_cast(unsigned, x), __builtin_bit_cast(unsigned, x), false, false);
    const unsigned a = rr[0], b = rr[1]; lo = __builtin_bit_cast(float, a); hi = __builtin_bit_cast(float, b); }
__device__ __forceinline__ float pair_max(float x) { float a, b; pair_swap(x, a, b); return fmaxf(a, b); }
__device__ __forceinline__ float pair_sum(float x) { float a, b; pair_swap(x, a, b); return a + b; }
__device__ __forceinline__ bf16x8 pack_frag(const f32x16& p, int b0) { u32x4 w; w.x = cvt_pk_bf16(p[b0 + 0], p[b0 + 1]); w.y = cvt_pk_bf16(p[b0 + 2], p[b0 + 3]); w.z = cvt_pk_bf16(p[b0 + 4], p[b0 + 5]); w.w = cvt_pk_bf16(p[b0 + 6], p[b0 + 7]); return __builtin_bit_cast(bf16x8, w); }
constexpr int crow_c(int r) { return (r & 3) + 8 * (r >> 2); }

__device__ __forceinline__ float sb_block(f32x16& z, float Rbase, bool need_mask, int dq, int koff, int hi) {
    float sp[16];
#pragma unroll
    for (int r = 0; r < 16; ++r) { const float zz = z[r]; sp[r] = fmaxf(zz, 0.f) + fast_log2(1.0f + fast_exp2(-fabsf(zz))); if (need_mask && !(crow_c(r) + koff < dq)) sp[r] = 0.f; }
    float lo[4], hg[4];
#pragma unroll
    for (int a = 0; a < 4; ++a) { const float gs = (sp[4 * a] + sp[4 * a + 1]) + (sp[4 * a + 2] + sp[4 * a + 3]);
        pair_swap(gs, lo[a], hg[a]); }
    float SG[8]; float run = 0.f;
#pragma unroll
    for (int G = 7; G >= 0; --G) { SG[G] = run; run += (G & 1) ? hg[G >> 1] : lo[G >> 1]; }
#pragma unroll
    for (int a = 0; a < 4; ++a) { float C = Rbase + (hi ? SG[2 * a + 1] : SG[2 * a]);
#pragma unroll
        for (int i = 3; i >= 0; --i) { const int r = 4 * a + i; float wv = fast_exp2(z[r] - sp[r] - C); C += sp[r]; if (need_mask && !(crow_c(r) + koff < dq)) wv = 0.f; z[r] = wv; } }
    return run;
}

template <int MODE>
__device__ __forceinline__ void attn_unit(LAS unsigned char* lds, const bf16* P, const bf16* KV, bf16* O, int b, int h, int qb, int tid, unsigned* dbg = nullptr) {
    constexpr int DQK = MODE ? 192 : 128, NCH = DQK / 8, NKS = DQK / 16, KS = DQK * 2 + 16, VS = 320;
    constexpr int KBUF = 64 * KS, VBUF = 64 * VS, VOFF = 2 * KBUF, NKC = NCH * 64 / 512, EXOFF = 120 * 1024;
    const int lane = tid & 63, w = __builtin_amdgcn_readfirstlane(tid >> 6), l31 = lane & 31, hi = lane >> 5;
    const size_t rowb = (size_t)b * SEQ;
    const int q0 = qb * 256 + w * 32;
    bf16x8 qf[NKS];
    { const bf16* qrow = P + (rowb + q0 + l31) * NP;
#pragma unroll
      for (int ks = 0; ks < NKS; ++ks) { const bf16* src;
          if (MODE == 0) src = qrow + PC_SBQ + h * 128 + ks * 16 + 8 * hi;
          else if (ks < 8) src = qrow + PC_MQN + h * 128 + ks * 16 + 8 * hi;
          else if (ks < 10) src = qrow + PC_MQP + h * 32 + (ks - 8) * 16 + 8 * hi;
          else src = qrow + PC_MQP + 128 + h * 32 + (ks - 10) * 16 + 8 * hi;
          qf[ks] = *(const bf16x8*)src; } }
    const unsigned char* wsb = (const unsigned char*)P - WS_P;
    unsigned kp[NKC], vp[2]; int kw[NKC], vw[2]; unsigned kstride[NKC];
#pragma unroll
    for (int i = 0; i < NKC; ++i) { const int idx = tid + 512 * i, r = idx / NCH, c = idx % NCH; kw[i] = r * KS + c * 16;
        if (MODE == 0) { kp[i] = (unsigned)(WS_P + ((rowb + r) * NP + PC_SBK + h * 128 + c * 8) * 2); kstride[i] = 64u * NP * 2u; }
        else if (c < 16) { kp[i] = (unsigned)(WS_KV + ((rowb + r) * 1024 + h * 256 + c * 8) * 2); kstride[i] = 64u * 1024u * 2u; }
        else if (c < 20) { kp[i] = (unsigned)(WS_P + ((rowb + r) * NP + PC_KPE + (c - 16) * 8) * 2); kstride[i] = 64u * NP * 2u; }
        else { kp[i] = (unsigned)(WS_P + ((rowb + r) * NP + PC_KPE + 128 + (c - 20) * 8) * 2); kstride[i] = 64u * NP * 2u; } }
#pragma unroll
    for (int i = 0; i < 2; ++i) { const int idx = tid + 512 * i, r = idx >> 4, c = idx & 15; vw[i] = VOFF + r * VS + c * 16;
        vp[i] = MODE ? (unsigned)(WS_KV + ((rowb + r) * 1024 + h * 256 + 128 + c * 8) * 2) : (unsigned)(WS_P + ((rowb + r) * NP + PC_SBV + h * 128 + c * 8) * 2); }
    constexpr unsigned vstride = MODE ? 64u * 1024u * 2u : 64u * NP * 2u;
    const int njt = 4 * qb + 4;
    f32x16 o[4];
#pragma unroll
    for (int nb = 0; nb < 4; ++nb)
#pragma unroll
        for (int r = 0; r < 16; ++r) o[nb][r] = 0.f;
    float m_run = -1e30f, l_run = 0.f, Rsum = 0.f;
    if (MODE == 0 && tid < 3) *(volatile LAS unsigned*)(lds + EXOFF + 4 * tid) = 0u;
    u32x4 kreg[NKC], vreg[2];
    { const int jt = MODE ? 0 : njt - 1;
#pragma unroll
      for (int i = 0; i < NKC; ++i) kreg[i] = *(const u32x4*)(wsb + (kp[i] + (unsigned)jt * kstride[i]));
#pragma unroll
      for (int i = 0; i < 2; ++i) vreg[i] = *(const u32x4*)(wsb + (vp[i] + (unsigned)jt * vstride));
#pragma unroll
      for (int i = 0; i < NKC; ++i) *(LAS u32x4*)(lds + kw[i]) = kreg[i];
#pragma unroll
      for (int i = 0; i < 2; ++i) *(LAS u32x4*)(lds + vw[i]) = vreg[i];
    }
    __syncthreads();
#if DIAG
    if (dbg) {
        const int jt0 = MODE ? 0 : njt - 1; unsigned badv = 0, badk = 0, badt = 0;
        _Pragma("unroll") for (int i = 0; i < 2; ++i) { const u32x4 a = *(LAS u32x4*)(lds + vw[i]); const u32x4 g = *(const u32x4*)(wsb + (vp[i] + (unsigned)jt0 * vstride)); if (a.x != g.x || a.y != g.y || a.z != g.z || a.w != g.w) ++badv; }
        _Pragma("unroll") for (int i = 0; i < NKC; ++i) { const u32x4 a = *(LAS u32x4*)(lds + kw[i]); const u32x4 g = *(const u32x4*)(wsb + (kp[i] + (unsigned)jt0 * kstride[i])); if (a.x != g.x || a.y != g.y || a.z != g.z || a.w != g.w) ++badk; }
        { const lds_cptr vbx = (lds_cptr)lds + VOFF + (4 * hi + ((lane & 15) >> 2)) * VS + ((lane >> 4) & 1) * 32 + (lane & 3) * 8;
          _Pragma("unroll 1") for (int nb = 0; nb < 4; ++nb) _Pragma("unroll 1") for (int kk = 0; kk < 4; ++kk) _Pragma("unroll 1") for (int e = 0; e < 2; ++e) { const s16x4 v = vtr(vbx + (kk * 16 + 8 * e) * VS + nb * 64);
              _Pragma("unroll") for (int q = 0; q < 4; ++q) { const int key = jt0 * 64 + kk * 16 + 8 * e + 4 * hi + q; const bf16 g = MODE ? KV[(rowb + key) * 1024 + h * 256 + 128 + 32 * nb + l31] : P[(rowb + key) * NP + PC_SBV + h * 128 + 32 * nb + l31];
                  if ((unsigned short)v[q] != g) ++badt; } } }
        if (badv) atomicAdd(dbg + 440, badv); if (badk) atomicAdd(dbg + 441, badk); if (badt) atomicAdd(dbg + 442, badt); atomicAdd(dbg + 445, 1u);
    }
#endif
    const lds_cptr kb0 = (lds_cptr)lds + l31 * KS + hi * 16;
    const lds_cptr vb0 = (lds_cptr)lds + VOFF + (4 * hi + ((lane & 15) >> 2)) * VS + ((lane >> 4) & 1) * 32 + (lane & 3) * 8;
    for (int it = 0; it < njt; ++it) {
        const int jt = MODE ? it : njt - 1 - it, buf = it & 1;
        const bool more = (it + 1 < njt);
        if (more) { const int jn = MODE ? jt + 1 : jt - 1;
#pragma unroll
            for (int i = 0; i < NKC; ++i) kreg[i] = *(const u32x4*)(wsb + (kp[i] + (unsigned)jn * kstride[i]));
#pragma unroll
            for (int i = 0; i < 2; ++i) vreg[i] = *(const u32x4*)(wsb + (vp[i] + (unsigned)jn * vstride)); }
        const int k0 = jt * 64;
        const bool skip = NOSKIP ? false : (MODE ? (k0 > q0 + 31) : (k0 >= q0 + 31));
        if (!skip) {
            const bool need_mask = MODE ? (k0 + 63 > q0) : (k0 + 63 >= q0);
            const int dq = q0 + l31 - k0 - 4 * hi;
            f32x16 s0, s1;
#pragma unroll
            for (int r = 0; r < 16; ++r) { s0[r] = 0.f; s1[r] = 0.f; }
            const lds_cptr kb_ = kb0 + buf * KBUF;
            { bf16x8 kf0 = *(const LAS bf16x8*)(kb_), kf1 = *(const LAS bf16x8*)(kb_ + 32 * KS);
#pragma unroll
              for (int ks = 0; ks < NKS; ++ks) { bf16x8 nf0 = kf0, nf1 = kf1;
                  if (ks + 1 < NKS) { nf0 = *(const LAS bf16x8*)(kb_ + (ks + 1) * 32); nf1 = *(const LAS bf16x8*)(kb_ + 32 * KS + (ks + 1) * 32); }
                  s0 = __builtin_amdgcn_mfma_f32_32x32x16_bf16(kf0, qf[ks], s0, 0, 0, 0); s1 = __builtin_amdgcn_mfma_f32_32x32x16_bf16(kf1, qf[ks], s1, 0, 0, 0);
                  kf0 = nf0; kf1 = nf1; } }
            if (MODE == 0) {
                const float t1 = sb_block(s1, Rsum, need_mask, dq, 32, hi);
                const float t0 = sb_block(s0, Rsum + t1, need_mask, dq, 0, hi);
                Rsum += t1 + t0;
            } else {
#if DIAG_UNIFORM
#pragma unroll
                for (int r = 0; r < 16; ++r) { s0[r] = 0.f; s1[r] = 0.f; }
#endif
                if (need_mask) { const float NEG = -__builtin_inff();
#pragma unroll
                    for (int r = 0; r < 16; ++r) { if (!(crow_c(r) <= dq)) s0[r] = NEG; if (!(crow_c(r) + 32 <= dq)) s1[r] = NEG; } }
                float pm = s0[0];
#pragma unroll
                for (int r = 1; r < 16; ++r) pm = fmaxf(pm, s0[r]);
#pragma unroll
                for (int r = 0; r < 16; ++r) pm = fmaxf(pm, s1[r]);
                pm = pair_max(pm);
                float mn = m_run, alpha = 1.f;
                if (!__all(pm - m_run <= 8.0f)) {
                    mn = fmaxf(m_run, pm); alpha = fast_exp2(m_run - mn); m_run = mn;
#pragma unroll
                    for (int nb = 0; nb < 4; ++nb)
#pragma unroll
                        for (int r = 0; r < 16; ++r) o[nb][r] *= alpha; }
                float ps = 0.f;
#pragma unroll
                for (int r = 0; r < 16; ++r) { s0[r] = fast_exp2(s0[r] - mn); s1[r] = fast_exp2(s1[r] - mn); ps += s0[r] + s1[r]; }
                ps = pair_sum(ps); l_run = l_run * alpha + ps;
            }
            bf16x8 pa[4]; pa[0] = pack_frag(s0, 0); pa[1] = pack_frag(s0, 8); pa[2] = pack_frag(s1, 0); pa[3] = pack_frag(s1, 8);
#if DIAG
            if (dbg && it == 0 && w == 0 && (lane == 0 || lane == 32)) { unsigned nz = 0; _Pragma("unroll") for (int kk = 0; kk < 4; ++kk) _Pragma("unroll") for (int j = 0; j < 8; ++j) if (pa[kk][j] != 0) ++nz;
                atomicAdd(dbg + 443, nz); if (lane == 0) { dbg[444] = (unsigned)(l_run * 1000.0f); dbg[446] = (unsigned)(unsigned short)pa[0][0]; dbg[447] = (unsigned)(m_run * 100.0f + 10000.0f); } }
#endif
            const lds_cptr vb_ = vb0 + buf * VBUF;
            { s16x4 v0 = vtr(vb_), v1 = vtr(vb_ + 8 * VS);
#pragma unroll
              for (int st = 0; st < 16; ++st) { const int nb = st >> 2, kk = st & 3; s16x4 n0 = v0, n1 = v1;
                  if (st + 1 < 16) { const int nb2 = (st + 1) >> 2, kk2 = (st + 1) & 3; n0 = vtr(vb_ + (kk2 * 16) * VS + nb2 * 64); n1 = vtr(vb_ + (kk2 * 16 + 8) * VS + nb2 * 64); }
                  bf16x8 vf; vf[0] = v0[0]; vf[1] = v0[1]; vf[2] = v0[2]; vf[3] = v0[3]; vf[4] = v1[0]; vf[5] = v1[1]; vf[6] = v1[2]; vf[7] = v1[3];
                  o[nb] = __builtin_amdgcn_mfma_f32_32x32x16_bf16(vf, pa[kk], o[nb], 0, 0, 0);
                  v0 = n0; v1 = n1; } }
        }
        if (more) {
#pragma unroll
            for (int i = 0; i < NKC; ++i) *(LAS u32x4*)(lds + (buf ^ 1) * KBUF + kw[i]) = kreg[i];
#pragma unroll
            for (int i = 0; i < 2; ++i) *(LAS u32x4*)(lds + (buf ^ 1) * VBUF + vw[i]) = vreg[i]; }
        if (MODE == 0) {
            if (__all(Rsum > 160.f) && lane == 0) __hip_atomic_fetch_or((unsigned*)(lds + EXOFF) + (it % 3), 1u << w, __ATOMIC_RELAXED, __HIP_MEMORY_SCOPE_WORKGROUP);
            __syncthreads();
            const unsigned dm = *(volatile LAS unsigned*)(lds + EXOFF + 4 * (it % 3));
            if (tid == 0) *(volatile LAS unsigned*)(lds + EXOFF + 4 * ((it + 2) % 3)) = 0u;
            if (dm == 0xffu) break;
        } else __syncthreads();
    }
    const float inv = MODE ? fast_rcp(l_run) : 1.0f;
    bf16* orow = O + (rowb + q0 + l31) * DM + (MODE ? OC_MLA : OC_SB) + h * 128 + 4 * hi;
#pragma unroll
    for (int nb = 0; nb < 4; ++nb)
#pragma unroll
        for (int g4 = 0; g4 < 4; ++g4) { u32x2 wv; wv.x = cvt_pk_bf16(o[nb][4 * g4] * inv, o[nb][4 * g4 + 1] * inv); wv.y = cvt_pk_bf16(o[nb][4 * g4 + 2] * inv, o[nb][4 * g4 + 3] * inv);
            *(u32x2*)(orow + 32 * nb + 8 * g4) = wv; }
}


constexpr size_t MX_RKV = 0, MX_RSB = 32 * MiB, MX_LHL = 48 * MiB, MX_LCA = 80 * MiB, MX_LTA = 112 * MiB, MX_LTB = 112 * MiB + 512 * 1024, MX_LCR = 113 * MiB;
constexpr int TVS = 320;
constexpr float RET_GC = 128.0f;
__device__ __forceinline__ int ret_col(int hb, int ks, int hi) { return hb + 16 * ks + 8 * hi + (ks >= 4 ? 64 : 0); }
__device__ __forceinline__ bf16x8 tr_frag(lds_cptr p) { const s16x4 v0 = vtr(p), v1 = vtr(p + 8 * TVS); bf16x8 f; f[0] = v0[0]; f[1] = v0[1]; f[2] = v0[2]; f[3] = v0[3]; f[4] = v1[0]; f[5] = v1[1]; f[6] = v1[2]; f[7] = v1[3]; return f; }

__device__ __forceinline__ void ret_kv_item(LAS unsigned char* lds, const bf16* P, float* KVS, int item, int tid) {
    const int lane = tid & 63, w = __builtin_amdgcn_readfirstlane(tid >> 6), l31 = lane & 31, hi = lane >> 5;
    const int n = item & 15, h = (item >> 4) & 3, b = item >> 6;
    const size_t row0 = (size_t)b * SEQ + n * 128;
    const int hbk = PC_RK + (h >> 1) * 256 + (h & 1) * 64;
    constexpr int KOFF = 128 * TVS;
    { u32x4 sv[4], sk[4];
#pragma unroll
      for (int i = 0; i < 4; ++i) { const int idx = tid + 512 * i, r = idx >> 4, c = idx & 15; const bf16* rowp = P + (row0 + r) * NP;
          sv[i] = *(const u32x4*)(rowp + PC_RV + h * 128 + c * 8); sk[i] = *(const u32x4*)(rowp + hbk + (c < 8 ? c * 8 : 128 + (c - 8) * 8)); }
      __builtin_amdgcn_sched_barrier(0);
#pragma unroll
      for (int i = 0; i < 4; ++i) { const int idx = tid + 512 * i, r = idx >> 4, c = idx & 15;
          *(LAS u32x4*)(lds + r * TVS + c * 16) = sv[i]; *(LAS u32x4*)(lds + KOFF + r * TVS + c * 16) = sk[i]; } }
    __syncthreads();
    const lds_cptr tb = (lds_cptr)lds + (4 * hi + ((lane & 15) >> 2)) * TVS + ((lane >> 4) & 1) * 32 + (lane & 3) * 8;
#pragma unroll
    for (int tt = 0; tt < 2; ++tt) { const int ti = 2 * w + tt, dvt = ti >> 2, dt = ti & 3;
        f32x16 acc;
#pragma unroll
        for (int r = 0; r < 16; ++r) acc[r] = 0.f;
#pragma unroll
        for (int ks = 0; ks < 8; ++ks) { const bf16x8 af = tr_frag(tb + (16 * ks) * TVS + dvt * 64), bfr = tr_frag(tb + KOFF + (16 * ks) * TVS + dt * 64);
            acc = __builtin_amdgcn_mfma_f32_32x32x16_bf16(af, bfr, acc, 0, 0, 0); }
        bf16* op = (bf16*)KVS + (size_t)item * 16384 + (size_t)(32 * dvt + 4 * hi) * 128 + 32 * dt + l31;
#pragma unroll
        for (int r = 0; r < 16; ++r) op[(size_t)crow_c(r) * 128] = (bf16)f2bf(acc[r]); }
    __syncthreads();
}
__device__ __forceinline__ void ret_scan_item(const float* KVS, bf16* SB16, int item, int tid) {
    const int bh = item >> 2, qtr = item & 3, h = bh & 3; const size_t e0 = (size_t)qtr * 4096 + (size_t)tid * 8;
    const float lg = lg2_gamma(h), g1 = exp2f(lg), gC = exp2f(lg * RET_GC), gC1 = exp2f(lg * (RET_GC - 1.0f));
    f32x4 s0 = {0.f, 0.f, 0.f, 0.f}, s1 = {0.f, 0.f, 0.f, 0.f};
    f32x4 kv[15][2];
#pragma unroll
    for (int n = 0; n < 15; ++n) { const size_t off = ((size_t)bh * 16 + n) * 16384 + e0; const u32x4 w = *(const u32x4*)((const bf16*)KVS + off);
        kv[n][0] = (f32x4){bflo(w.x), bfhi(w.x), bflo(w.y), bfhi(w.y)}; kv[n][1] = (f32x4){bflo(w.z), bfhi(w.z), bflo(w.w), bfhi(w.w)}; }
#pragma unroll
    for (int n = 0; n < 16; ++n) { const size_t off = ((size_t)bh * 16 + n) * 16384 + e0;
        *(u32x4*)(SB16 + off) = pack8(s0 * g1, s1 * g1);
        if (n < 15) { s0 = s0 * gC + kv[n][0] * gC1; s1 = s1 * gC + kv[n][1] * gC1; } }
}
__device__ __forceinline__ void ret_out_item(LAS unsigned char* lds, const bf16* P, const bf16* SB16, bf16* O, int item, int tid) {
    const int lane = tid & 63, w = __builtin_amdgcn_readfirstlane(tid >> 6), l31 = lane & 31, hi = lane >> 5;
    const int pr = item & 7, bh = item >> 3, h = bh & 3, b = bh >> 2, ch = w >> 2, qg = w & 3, n = pr * 2 + ch;
    const size_t rowp0 = (size_t)b * SEQ + pr * 256;
    const size_t row0 = rowp0 + ch * 128;
    const int hbq = PC_RQ + (h >> 1) * 256 + (h & 1) * 64, hbk = PC_RK + (h >> 1) * 256 + (h & 1) * 64;
    constexpr int VT = 128 * TVS;
#pragma unroll
    for (int i = 0; i < 8; ++i) { const int idx = tid + 512 * i, r = idx >> 4, c = idx & 15;
        *(LAS u32x4*)(lds + r * TVS + c * 16) = *(const u32x4*)(P + (rowp0 + r) * NP + PC_RV + h * 128 + c * 8); }
    bf16x8 qf[8];
    { const bf16* qrow = P + (row0 + qg * 32 + l31) * NP;
#pragma unroll
      for (int ks = 0; ks < 8; ++ks) qf[ks] = *(const bf16x8*)(qrow + ret_col(hbq, ks, hi)); }
    __syncthreads();
    f32x16 o[4];
#pragma unroll
    for (int nb = 0; nb < 4; ++nb)
#pragma unroll
        for (int r = 0; r < 16; ++r) o[nb][r] = 0.f;
    const lds_cptr tb = (lds_cptr)lds + ch * VT + (4 * hi + ((lane & 15) >> 2)) * TVS + ((lane >> 4) & 1) * 32 + (lane & 3) * 8;
    for (int kb = 0; kb <= qg; ++kb) {
        f32x16 sc;
#pragma unroll
        for (int r = 0; r < 16; ++r) sc[r] = 0.f;
        const bf16* krow = P + (row0 + kb * 32 + l31) * NP;
#pragma unroll
        for (int ks = 0; ks < 8; ++ks) { const bf16x8 kf = *(const bf16x8*)(krow + ret_col(hbk, ks, hi)); sc = __builtin_amdgcn_mfma_f32_32x32x16_bf16(kf, qf[ks], sc, 0, 0, 0); }
        if (kb == qg) {
#pragma unroll
            for (int r = 0; r < 16; ++r) if (!(crow_c(r) + 4 * hi <= l31)) sc[r] = 0.f; }
        const bf16x8 p0 = pack_frag(sc, 0), p1 = pack_frag(sc, 8);
#pragma unroll
        for (int nb = 0; nb < 4; ++nb) { o[nb] = __builtin_amdgcn_mfma_f32_32x32x16_bf16(tr_frag(tb + (kb * 32) * TVS + nb * 64), p0, o[nb], 0, 0, 0);
                                         o[nb] = __builtin_amdgcn_mfma_f32_32x32x16_bf16(tr_frag(tb + (kb * 32 + 16) * TVS + nb * 64), p1, o[nb], 0, 0, 0); }
    }
    { const bf16* sbp = SB16 + ((size_t)bh * 16 + n) * 16384 + (size_t)l31 * 128 + 8 * hi;
#pragma unroll
      for (int nb = 0; nb < 4; ++nb)
#pragma unroll
          for (int ks = 0; ks < 8; ++ks) { const bf16x8 af = *(const bf16x8*)(sbp + (size_t)(32 * nb) * 128 + 16 * ks); o[nb] = __builtin_amdgcn_mfma_f32_32x32x16_bf16(af, qf[ks], o[nb], 0, 0, 0); } }
    float ss = 0.f;
#pragma unroll
    for (int nb = 0; nb < 4; ++nb)
#pragma unroll
        for (int r = 0; r < 16; ++r) ss += o[nb][r] * o[nb][r];
    ss = pair_sum(ss);
    const float rs = 1.0f / sqrtf(ss * (1.f / 128.f) + EPS);
    const size_t orow = row0 + qg * 32 + l31;
    const bf16* gp = P + orow * NP + PC_RG + h * 128 + 4 * hi; bf16* op = O + orow * DM + OC_RET + h * 128 + 4 * hi;
#pragma unroll
    for (int nb = 0; nb < 4; ++nb)
#pragma unroll
        for (int g4 = 0; g4 < 4; ++g4) { const u32x2 gw = *(const u32x2*)(gp + 32 * nb + 8 * g4);
            u32x2 wv; wv.x = cvt_pk_bf16(o[nb][4 * g4] * rs * bflo(gw.x), o[nb][4 * g4 + 1] * rs * bfhi(gw.x)); wv.y = cvt_pk_bf16(o[nb][4 * g4 + 2] * rs * bflo(gw.y), o[nb][4 * g4 + 3] * rs * bfhi(gw.y));
            *(u32x2*)(op + 32 * nb + 8 * g4) = wv; }
    __syncthreads();
}
struct LruParams { const float* cw; const float* cb; const float* ba; const float* bx; const float* lam; const bf16* WL; };
__device__ __forceinline__ void lru_local_item(LAS unsigned char* lds, const bf16* P, const LruParams& L, float* HL, float* CA, float* TA, float* TB, int item, int tid) {
    const int lane = tid & 63, w = __builtin_amdgcn_readfirstlane(tid >> 6), l31 = lane & 31, hi = lane >> 5;
    const int span = item & 15, blk = (item >> 4) & 3, b = item >> 6, t0 = span * 128;
    const size_t row0 = (size_t)b * SEQ + t0;
    constexpr int XS = 272;
    { const int c8 = tid & 15, tg = tid >> 4, ch0 = blk * 128 + c8 * 8;
      float xv[7][8];
#pragma unroll
      for (int j = 0; j < 7; ++j) { const int t = t0 + 4 * tg - 3 + j; u32x4 wv = {0u, 0u, 0u, 0u}; if (t >= 0) wv = *(const u32x4*)(P + ((size_t)b * SEQ + t) * NP + PC_LX + ch0);
          xv[j][0] = bflo(wv.x); xv[j][1] = bfhi(wv.x); xv[j][2] = bflo(wv.y); xv[j][3] = bfhi(wv.y); xv[j][4] = bflo(wv.z); xv[j][5] = bfhi(wv.z); xv[j][6] = bflo(wv.w); xv[j][7] = bfhi(wv.w); }
      float cwv[4][8], cbv[8];
#pragma unroll
      for (int tap = 0; tap < 4; ++tap) { const f32x4 a = *(const f32x4*)(L.cw + tap * 512 + ch0), c = *(const f32x4*)(L.cw + tap * 512 + ch0 + 4);
          cwv[tap][0] = a[0]; cwv[tap][1] = a[1]; cwv[tap][2] = a[2]; cwv[tap][3] = a[3]; cwv[tap][4] = c[0]; cwv[tap][5] = c[1]; cwv[tap][6] = c[2]; cwv[tap][7] = c[3]; }
      { const f32x4 a = *(const f32x4*)(L.cb + ch0), c = *(const f32x4*)(L.cb + ch0 + 4); cbv[0] = a[0]; cbv[1] = a[1]; cbv[2] = a[2]; cbv[3] = a[3]; cbv[4] = c[0]; cbv[5] = c[1]; cbv[6] = c[2]; cbv[7] = c[3]; }
#pragma unroll
      for (int tk = 0; tk < 4; ++tk) { float y[8];
#pragma unroll
          for (int e = 0; e < 8; ++e) { float a = cbv[e];
#pragma unroll
              for (int tap = 0; tap < 4; ++tap) a += xv[tk + tap][e] * cwv[tap][e];
              y[e] = a; }
          u32x4 o; o.x = cvt_pk_bf16(y[0], y[1]); o.y = cvt_pk_bf16(y[2], y[3]); o.z = cvt_pk_bf16(y[4], y[5]); o.w = cvt_pk_bf16(y[6], y[7]);
          *(LAS u32x4*)(lds + (4 * tg + tk) * XS + c8 * 16) = o; } }
    __syncthreads();
    const int cg = w & 3, th = w >> 2, chn = blk * 128 + cg * 32 + l31;
    f32x16 ra[2], rx[2];
#pragma unroll
    for (int tt = 0; tt < 2; ++tt)
#pragma unroll
        for (int r = 0; r < 16; ++r) { ra[tt][r] = 0.f; rx[tt][r] = 0.f; }
    { const bf16* wa = L.WL + (size_t)(blk * 128 + cg * 32 + l31) * 128 + 8 * hi; const bf16* wx = wa + 4 * 128 * 128;
      const lds_cptr xb = (lds_cptr)lds + (64 * th + l31) * XS + hi * 16;
#pragma unroll
      for (int ks = 0; ks < 8; ++ks) { const bf16x8 fa = *(const bf16x8*)(wa + 16 * ks), fx = *(const bf16x8*)(wx + 16 * ks);
#pragma unroll
          for (int tt = 0; tt < 2; ++tt) { const bf16x8 xf = *(const LAS bf16x8*)(xb + (32 * tt) * XS + ks * 32);
              ra[tt] = __builtin_amdgcn_mfma_f32_32x32x16_bf16(xf, fa, ra[tt], 0, 0, 0); rx[tt] = __builtin_amdgcn_mfma_f32_32x32x16_bf16(xf, fx, rx[tt], 0, 0, 0); } } }
    { const float bav = L.ba[chn], bxv = L.bx[chn], lm = L.lam[chn];
      const float spl = fmaxf(-lm, 0.f) + log1pf(expf(-fabsf(lm)));
      const float c8l = -8.0f * spl * LOG2E;
      const LAS bf16* xcol = (const LAS bf16*)(lds + (64 * th + 4 * hi) * XS) + cg * 32 + l31;
#pragma unroll
      for (int tt = 0; tt < 2; ++tt)
#pragma unroll
          for (int r = 0; r < 16; ++r) { const float rr_ = sigmoidf_(ra[tt][r] + bav), ii = sigmoidf_(rx[tt][r] + bxv);
              const float a = fast_exp2(c8l * rr_); const float xcv = bf2f(xcol[(32 * tt + crow_c(r)) * (XS / 2)]);
              ra[tt][r] = a; rx[tt][r] = sqrtf(fmaxf(1.0f - a * a, 0.f)) * (ii * xcv); } }
    float cinO[8], pinO[8]; float c = 0.f, p = 1.f;
#pragma unroll
    for (int tt = 0; tt < 2; ++tt)
#pragma unroll
        for (int a = 0; a < 4; ++a) { float Ag = 1.f, Bg = 0.f;
#pragma unroll
            for (int i = 0; i < 4; ++i) { const float av = ra[tt][4 * a + i]; Bg = av * Bg + rx[tt][4 * a + i]; Ag *= av; }
            float A0, A1, B0, B1; pair_swap(Ag, A0, A1); pair_swap(Bg, B0, B1);
            const float cm = A0 * c + B0, pm = p * A0;
            cinO[4 * tt + a] = hi ? cm : c; pinO[4 * tt + a] = hi ? pm : p;
            c = A1 * cm + B1; p = pm * A1; }
    const size_t rowb = row0 + 64 * th + 4 * hi;
#pragma unroll
    for (int tt = 0; tt < 2; ++tt)
#pragma unroll
        for (int a = 0; a < 4; ++a) { float hh = cinO[4 * tt + a], pp = pinO[4 * tt + a];
#pragma unroll
            for (int i = 0; i < 4; ++i) { const float av = ra[tt][4 * a + i]; hh = av * hh + rx[tt][4 * a + i]; pp *= av;
                const size_t o_ = (rowb + 32 * tt + 8 * a + i) * 512 + chn; ((bf16*)HL)[o_] = (bf16)f2bf(hh); ((bf16*)CA)[o_] = (bf16)f2bf(pp); } }
    if (hi == 0) { const size_t o_ = ((size_t)b * 32 + span * 2 + th) * 512 + chn; TA[o_] = p; TB[o_] = c; }
    __syncthreads();
}
__device__ __forceinline__ void lru_carry(const float* TA, const float* TB, float* CR, int gtid, int gstride) {
    for (int i = gtid; i < BATCH * 512; i += gstride) { const int b = i >> 9, chn = i & 511; float c = 0.f; float ta[32], tb[32];
#pragma unroll
        for (int ck = 0; ck < 32; ++ck) { const size_t o_ = ((size_t)b * 32 + ck) * 512 + chn; ta[ck] = TA[o_]; tb[ck] = TB[o_]; }
#pragma unroll
        for (int ck = 0; ck < 32; ++ck) { const size_t o_ = ((size_t)b * 32 + ck) * 512 + chn; CR[o_] = c; c = ta[ck] * c + tb[ck]; } }
}
__device__ __forceinline__ void lru_fix(const bf16* P, const float* HL, const float* CA, const float* CR, bf16* O, int gtid, int gstride, int iend) {
    for (int i = gtid; i < iend; i += gstride) { const int c8 = i & 63; const size_t row = (size_t)(i >> 6); const int b = (int)(row >> 11), t = (int)(row & (SEQ - 1));
        const size_t o_ = row * 512 + c8 * 8; const size_t cr = ((size_t)b * 32 + (t >> 6)) * 512 + c8 * 8;
        const u32x4 hw = *(const u32x4*)((const bf16*)HL + o_), aw = *(const u32x4*)((const bf16*)CA + o_); const f32x4 c0 = *(const f32x4*)(CR + cr), c1 = *(const f32x4*)(CR + cr + 4);
        const f32x4 h0 = {bflo(hw.x), bfhi(hw.x), bflo(hw.y), bfhi(hw.y)}, h1 = {bflo(hw.z), bfhi(hw.z), bflo(hw.w), bfhi(hw.w)}, a0 = {bflo(aw.x), bfhi(aw.x), bflo(aw.y), bfhi(aw.y)}, a1 = {bflo(aw.z), bfhi(aw.z), bflo(aw.w), bfhi(aw.w)};
        const u32x4 yw = *(const u32x4*)(P + row * NP + PC_LY + c8 * 8);
        const f32x4 y0 = {bflo(yw.x), bfhi(yw.x), bflo(yw.y), bfhi(yw.y)}, y1 = {bflo(yw.z), bfhi(yw.z), bflo(yw.w), bfhi(yw.w)};
        *(u32x4*)(O + row * DM + OC_LRU + c8 * 8) = pack8((h0 + a0 * c0) * y0, (h1 + a1 * c1) * y1); }
}

struct Args { const float* in[21]; float* out; unsigned char* ws; int ph_lo, ph_hi, li, pad; };
#define GIN(A_, i_) ((const float*)(const GAS float*)(A_).in[i_])
struct Frame {
    LAS unsigned char* lds; volatile LAS unsigned* MISC; gu32* ctl;
    int tid, lane, wave, G, bid;
    float* out; unsigned char* ws;
};
__device__ __forceinline__ float wave_sum(float v, int lane) {
#pragma unroll
    for (int o = 1; o < 64; o <<= 1) v += __builtin_bit_cast(float, __builtin_amdgcn_ds_bpermute((lane ^ o) << 2, __builtin_bit_cast(int, v)));
    return v;
}

__device__ __forceinline__ void transpose_item(const float* src, int ld, int col0, int k0, float scale, const float* kscale, bf16* dst, int K, LAS unsigned char* scr, int lane) {
    const int n4 = lane & 7, ks = lane >> 3;
    if (src) {
        f32x4 v[16];
        const float* sp = src + (size_t)(k0 + 16 * ks) * ld + col0 + 4 * n4;
#pragma unroll
        for (int i = 0; i < 16; ++i) v[i] = *(const GAS f32x4*)(sp + (size_t)i * ld);
        if (kscale) {
#pragma unroll
            for (int i = 0; i < 16; i += 4) { const f32x4 kk = *(const GAS f32x4*)(kscale + k0 + 16 * ks + i); v[i] *= kk[0]; v[i + 1] *= kk[1]; v[i + 2] *= kk[2]; v[i + 3] *= kk[3]; } }
#pragma unroll
        for (int j = 0; j < 4; ++j)
#pragma unroll
            for (int c = 0; c < 2; ++c) { u32x4 o;
                o.x = pk2(v[8 * c + 0][j] * scale, v[8 * c + 1][j] * scale); o.y = pk2(v[8 * c + 2][j] * scale, v[8 * c + 3][j] * scale);
                o.z = pk2(v[8 * c + 4][j] * scale, v[8 * c + 5][j] * scale); o.w = pk2(v[8 * c + 6][j] * scale, v[8 * c + 7][j] * scale);
                *(LAS u32x4*)(scr + (4 * n4 + j) * 272 + (16 * ks + 8 * c) * 2) = o; }
    } else {
#pragma unroll
        for (int j = 0; j < 4; ++j)
#pragma unroll
            for (int c = 0; c < 2; ++c) *(LAS u32x4*)(scr + (4 * n4 + j) * 272 + (16 * ks + 8 * c) * 2) = (u32x4){0u, 0u, 0u, 0u};
    }
    LDS_WAIT(); asm volatile("" ::: "memory");
    const int c16 = lane & 15, r4 = lane >> 4;
#pragma unroll
    for (int i = 0; i < 8; ++i) { const int n = r4 + 4 * i; const u32x4 o = *(const LAS u32x4*)(scr + n * 272 + c16 * 16); *(GAS u32x4*)(dst + (size_t)n * K + k0 + 8 * c16) = o; }
    LDS_WAIT(); asm volatile("" ::: "memory");
}
__device__ __forceinline__ void transpose_item8(const float* src, int ld, int col0, int k0, float scale, const float* kscale, unsigned char* dst, int K, LAS unsigned char* scr, int lane) {
    const int n4 = lane & 7, ks = lane >> 3;
    f32x4 v[16];
    const float* sp = src + (size_t)(k0 + 16 * ks) * ld + (size_t)(n4 & 1) * DM * DM + col0 + 4 * (n4 >> 1);
#pragma unroll
    for (int i = 0; i < 16; ++i) v[i] = *(const GAS f32x4*)(sp + (size_t)i * ld);
    if (kscale) {
#pragma unroll
        for (int i = 0; i < 16; i += 4) { const f32x4 kk = *(const GAS f32x4*)(kscale + k0 + 16 * ks + i); v[i] *= kk[0]; v[i + 1] *= kk[1]; v[i + 2] *= kk[2]; v[i + 3] *= kk[3]; } }
#pragma unroll
    for (int j = 0; j < 4; ++j) { u32x4 o;
        o.x = pk4_fp8(v[0][j] * scale, v[1][j] * scale, v[2][j] * scale, v[3][j] * scale); o.y = pk4_fp8(v[4][j] * scale, v[5][j] * scale, v[6][j] * scale, v[7][j] * scale);
        o.z = pk4_fp8(v[8][j] * scale, v[9][j] * scale, v[10][j] * scale, v[11][j] * scale); o.w = pk4_fp8(v[12][j] * scale, v[13][j] * scale, v[14][j] * scale, v[15][j] * scale);
        *(LAS u32x4*)(scr + (4 * n4 + j) * 144 + 16 * ks) = o; }
    LDS_WAIT(); asm volatile("" ::: "memory");
    const int c8 = lane & 7, r8 = lane >> 3;
#pragma unroll
    for (int i = 0; i < 4; ++i) { const int n = r8 + 8 * i; const u32x4 o = *(const LAS u32x4*)(scr + n * 144 + c8 * 16); *(GAS u32x4*)(dst + (size_t)n * K + k0 + 16 * c8) = o; }
    LDS_WAIT(); asm volatile("" ::: "memory");
}
__device__ __forceinline__ void map_inproj(int g, const float* w_in, const float* w_gate, const float*& src, int& ld, int& col, float& scale) {
    const int t = g >> 3, c = (g & 7) * 32, half = c >> 7, ch = c & 127;
    src = w_in; ld = INW; scale = 1.f; col = 0;
    const float SBS = 0.08838834764831845f * LOG2E, MLS = 0.07216878364870323f * LOG2E, RKS = 0.08838834764831845f;
    if (t < 6) { col = t * 256 + c; if (t < 2) scale = SBS; }
    else if (t < 8) { const int hd = (t - 6) * 2 + half; col = 1536 + hd * 192 + ch; scale = MLS; }
    else if (t == 8) { const int hd = ch >> 5; col = 1536 + hd * 192 + 128 + half * 32; scale = MLS; }
    else if (t < 11) { col = 2304 + (t - 9) * 256 + c; }
    else if (t == 11) { if (ch < 32) col = 2816 + half * 32; else src = nullptr; }
    else if (t < 14) { const int hd = (t - 12) * 2 + (ch >> 6); col = 2880 + hd * 128 + half * 64 + (ch & 63); }
    else if (t < 16) { const int hd = (t - 14) * 2 + (ch >> 6); col = 3392 + hd * 128 + half * 64 + (ch & 63); scale = RKS; }
    else if (t < 24) { col = 3904 + (t - 16) * 256 + c; }
    else { src = w_gate + (size_t)(2 * half) * DM * DM; ld = DM; col = (t - 24) * 64 + 16 * (ch >> 5); scale = LOG2E; }
}
__device__ __forceinline__ void phase_convert(Frame& F, const Args& A, int layer) {
    LAS unsigned char* scr = F.lds + RING_OFF + F.wave * 16384;
    const int gw = F.bid * NWAVES + F.wave, NGW = F.G * NWAVES, lane = F.lane;
    const float* w_in = GIN(A, 3) + (size_t)layer * DM * INW; const float* w_gate = GIN(A, 14) + (size_t)layer * 4 * DM * DM;
    const float* ln1g = GIN(A, 2) + layer * DM; const float* ln2g = GIN(A, 16) + layer * DM;
    const float* kvg = GIN(A, 4) + layer * 512; const float* w_ukv = GIN(A, 5) + (size_t)layer * 512 * 1024;
    const float* w_br = GIN(A, 13) + (size_t)layer * 4 * 512 * DM; const float* w_out = GIN(A, 15) + (size_t)layer * DM * DM;
    const float* w_fg = GIN(A, 17) + (size_t)layer * DM * DFF; const float* w_fu = GIN(A, 18) + (size_t)layer * DM * DFF; const float* w_fd = GIN(A, 19) + (size_t)layer * DFF * DM;
    const float* w_la = GIN(A, 8) + (size_t)layer * 4 * 128 * 128; const float* w_lx = GIN(A, 10) + (size_t)layer * 4 * 128 * 128;
    bf16* WIN = (bf16*)(F.ws + WS_WIN); bf16* WUKV = (bf16*)(F.ws + WS_WUKV); bf16* WBR = (bf16*)(F.ws + WS_WBR); bf16* WOUT = (bf16*)(F.ws + WS_WOUT);
    bf16* WGU = (bf16*)(F.ws + WS_WGU); bf16* WDN = (bf16*)(F.ws + WS_WDN); bf16* WLRU = (bf16*)(F.ws + WS_WLRU);
    constexpr int I_IN = 448 * 16, I_UKV = 32 * 4, I_BR = 256 * 4, I_OUT = 64 * 16, I_GU = 352 * 16, I_DN = 64 * 44, I_LRU = 2 * 16;
    constexpr int NITEMS = I_IN + I_UKV + I_BR + I_OUT + I_GU + I_DN + I_LRU;
    for (int it = gw; it < NITEMS; it += NGW) {
        int r = it;
        if (r < I_IN) { const int kb = r / 448, g = r % 448; const float* src; int ld, col; float sc; map_inproj(g, w_in, w_gate, src, ld, col, sc);
            if (g < 192) transpose_item(src, ld, col, kb * 128, sc, ln1g, WIN + (size_t)g * 32 * DM, DM, scr, lane);
            else transpose_item8(src, ld, col, kb * 128, sc * F8_WSCALE, ln1g, (unsigned char*)(F.ws + WS_WG8) + (size_t)(g - 192) * 32 * DM, DM, scr, lane);
            continue; } r -= I_IN;
        if (r < I_UKV) { const int kb = r / 32, g = r % 32; transpose_item(w_ukv, 1024, g * 32, kb * 128, 1.f, kvg, WUKV + (size_t)g * 32 * 512, 512, scr, lane); continue; } r -= I_UKV;
        if (r < I_BR) { const int kb = r / 256, g = r % 256, b = g >> 6; transpose_item(w_br + (size_t)b * 512 * DM, DM, (g & 63) * 32, kb * 128, 1.f, nullptr, WBR + (size_t)g * 32 * 512, 512, scr, lane); continue; } r -= I_BR;
        if (r < I_OUT) { const int kb = r / 64, g = r % 64; transpose_item(w_out, DM, g * 32, kb * 128, 1.f, nullptr, WOUT + (size_t)g * 32 * DM, DM, scr, lane); continue; } r -= I_OUT;
        if (r < I_GU) { const int kb = r / 352, g = r % 352, t = g >> 3, c32 = g & 7; const float* src = (c32 >> 2) ? w_fu : w_fg;
            transpose_item(src, DFF, t * 128 + (c32 & 3) * 32, kb * 128, 1.f, ln2g, WGU + (size_t)g * 32 * DM, DM, scr, lane); continue; } r -= I_GU;
        if (r < I_DN) { const int kb = r / 64, g = r % 64; transpose_item(w_fd, DM, g * 32, kb * 128, 1.f, nullptr, WDN + (size_t)g * 32 * DFF, DFF, scr, lane); continue; } r -= I_DN;
        { const int which = r >> 4, g = r & 15, kb = 0, hb = g >> 2; const float* src = (which ? w_lx : w_la) + (size_t)hb * 128 * 128;
            transpose_item(src, 128, (g & 3) * 32, kb * 128, 1.f, nullptr, WLRU + (size_t)which * 4 * 128 * 128 + (size_t)g * 32 * 128, 128, scr, lane); }
    }
}
__device__ __forceinline__ void phase_rope_tables(Frame& F, const Args& A) {
    const int* pos = (const int*)GIN(A, 1);
    float* c32 = (float*)(F.ws + WS_ROPE); float* s32 = c32 + (size_t)M * 32; float* c64 = s32 + (size_t)M * 32; float* s64 = c64 + (size_t)M * 64;
    const size_t n = (size_t)M * 96, stride = (size_t)F.G * 512;
    for (size_t i = (size_t)F.bid * 512 + F.tid; i < n; i += stride) {
        const int m = (int)(i / 96), j = (int)(i % 96);
        const float p = (float)pos[m];
        if (j < 32) { const float fr = powf(10000.0f, -(float)(2 * j) / 64.0f); float sn, cs; sincosf(p * fr, &sn, &cs); c32[(size_t)m * 32 + j] = cs; s32[(size_t)m * 32 + j] = sn; }
        else { const int jj = j - 32; const float fr = powf(10000.0f, -(float)(2 * jj) / 128.0f); float sn, cs; sincosf(p * fr, &sn, &cs); c64[(size_t)m * 64 + jj] = cs; s64[(size_t)m * 64 + jj] = sn; }
    }
}
__device__ __forceinline__ void phase_prep(Frame& F, const float* x, bf16* X16, float* SS0, unsigned char* X8) {
    const int gw = F.bid * NWAVES + F.wave, NGW = F.G * NWAVES;
    for (int m = gw; m < M; m += NGW) {
        const GAS f32x4* xr = (const GAS f32x4*)(x + (size_t)m * DM) + F.lane; GAS u32x2* o = (GAS u32x2*)(X16 + (size_t)m * DM) + F.lane;
        f32x4 v[8]; float s = 0.f;
#pragma unroll
        for (int j = 0; j < 8; ++j) { v[j] = xr[64 * j]; s += (v[j].x * v[j].x + v[j].y * v[j].y) + (v[j].z * v[j].z + v[j].w * v[j].w); }
#pragma unroll
        for (int j = 0; j < 8; ++j) { u32x2 w; w.x = pk2(v[j].x, v[j].y); w.y = pk2(v[j].z, v[j].w); o[64 * j] = w;
            ((GAS unsigned*)(X8 + (size_t)m * DM))[64 * j + F.lane] = pk4_fp8(v[j].x, v[j].y, v[j].z, v[j].w); }
        s = wave_sum(s, F.lane); if (F.lane < 32) SS0[(size_t)m * 32 + F.lane] = (F.lane == 0) ? s : 0.f;
    }
}
__device__ __forceinline__ void phase_final(Frame& F, const bf16* X16, const float* SS, const float* gain, float* out) {
    const int gw = F.bid * NWAVES + F.wave, NGW = F.G * NWAVES;
    f32x4 g0[4], g1[4];
#pragma unroll
    for (int j = 0; j < 4; ++j) { g0[j] = *(const f32x4*)(gain + 512 * j + 8 * F.lane); g1[j] = *(const f32x4*)(gain + 512 * j + 8 * F.lane + 4); }
    for (int m = gw; m < M; m += NGW) { const float rs = 1.0f / sqrtf(wave_sum((F.lane < 32) ? SS[(size_t)m * 32 + F.lane] : 0.f, F.lane) * (1.f / DM) + EPS);
        const GAS u32x4* xr = (const GAS u32x4*)(X16 + (size_t)m * DM) + F.lane; GAS f32x4* o = (GAS f32x4*)(out + (size_t)m * DM) + 2 * F.lane;
#pragma unroll
        for (int j = 0; j < 4; ++j) { const u32x4 w = xr[64 * j];
            o[128 * j] = (f32x4){bflo(w.x), bfhi(w.x), bflo(w.y), bfhi(w.y)} * rs * g0[j]; o[128 * j + 1] = (f32x4){bflo(w.z), bfhi(w.z), bflo(w.w), bfhi(w.w)} * rs * g1[j]; } }
}

template <class Sched>
__device__ __forceinline__ RmsTab rms_table(Frame& F, const Sched& S, const float* SSP, LAS float* tbl) {
    RmsTab T; T.tbl = tbl; T.tag[0] = T.tag[1] = T.tag[2] = T.tag[3] = -1; int n = 0; Unit u;
    for (int i = 0; S.next(i, u); ++i) { if (u.pm == T.tag[0] || u.pm == T.tag[1] || u.pm == T.tag[2] || u.pm == T.tag[3] || n >= 4) continue;
        const int r = F.tid >> 1, hf = F.tid & 1; const float* p = SSP + ((size_t)u.pm * 256 + r) * 32 + hf * 16;
        const f32x4 a = *(const f32x4*)p, b = *(const f32x4*)(p + 4), c = *(const f32x4*)(p + 8), d = *(const f32x4*)(p + 12);
        float sm = (((a[0] + a[1]) + (a[2] + a[3])) + ((b[0] + b[1]) + (b[2] + b[3]))) + (((c[0] + c[1]) + (c[2] + c[3])) + ((d[0] + d[1]) + (d[2] + d[3])));
        const float other = __builtin_bit_cast(float, __builtin_amdgcn_ds_bpermute((F.lane ^ 1) << 2, __builtin_bit_cast(int, sm)));
        sm = hf ? (other + sm) : (sm + other);
        if (hf == 0) tbl[n * 256 + r] = 1.0f / sqrtf(sm * (1.f / DM) + EPS);
        if (n == 0) T.tag[0] = u.pm; else if (n == 1) T.tag[1] = u.pm; else if (n == 2) T.tag[2] = u.pm; else T.tag[3] = u.pm;
        ++n; }
    LDS_WAIT(); __syncthreads();
    return T;
}

__global__ void __launch_bounds__(NWAVES * 64, 2) mega_fwd(Args args) {
    extern __shared__ __attribute__((aligned(16))) unsigned char lds[];
    Frame F;
    F.lds = (LAS unsigned char*)lds; F.MISC = (volatile LAS unsigned*)(F.lds + MISC_OFF);
    F.tid = threadIdx.x; F.lane = F.tid & 63; F.wave = __builtin_amdgcn_readfirstlane(F.tid >> 6); F.G = gridDim.x; F.bid = blockIdx.x;
    F.ws = (unsigned char*)(GAS unsigned char*)args.ws; F.ctl = (gu32*)(args.ws + WS_CTL); F.out = (float*)(GAS float*)args.out;
    for (int u = F.tid; u < (LDS_BYTES - MISC_OFF) / 4; u += NWAVES * 64) ((LAS unsigned*)(F.lds + MISC_OFF))[u] = 0u;
    __syncthreads();
    XcdBarrier bar = xcd_barrier_post((unsigned*)(F.ctl + CW_BAR) + args.li * XCD_BAR_WORDS, F.MISC + 8);
    const int lo = args.ph_lo, hi = args.ph_hi;
    const int wave_u = __builtin_amdgcn_readfirstlane((int)threadIdx.x >> 6);
#define IN(k) (lo <= (k) && (k) < hi)
#define SEAM(k) do { if (IN(k) && (k) + 1 < hi) xcd_barrier(bar); } while (0)
#define PHASE_BEGIN() { GAS unsigned char* w_ = (GAS unsigned char*)args.ws; asm volatile("" : "+s"(w_)); F.ws = (unsigned char*)w_; GAS float* o_ = (GAS float*)args.out; asm volatile("" : "+s"(o_)); F.out = (float*)o_; \
          F.ctl = (gu32*)(w_ + WS_CTL); int z_ = 0; asm volatile("" : "+v"(z_)); int wv_ = wave_u; asm volatile("" : "+s"(wv_)); \
          F.lane = (int)__builtin_amdgcn_mbcnt_hi(~0u, __builtin_amdgcn_mbcnt_lo(~0u, (unsigned)z_)); F.wave = wv_; F.tid = (wv_ << 6) | F.lane; }
#define WSP(T, off) ((T*)(F.ws + (off)))
    for (int layer = 0; layer < DEPTH; ++layer) {
        const int pb = layer * 10;
        if (IN(pb + 0)) { PHASE_BEGIN();
            phase_convert(F, args, layer);
            if (layer == 0) phase_prep(F, GIN(args, 0), WSP(bf16, WS_H), WSP(float, WS_SSP), WSP(unsigned char, WS_X8));
        }
        SEAM(pb + 0);
        if (IN(pb + 1)) { PHASE_BEGIN();
            pg8::Gemm g{WSP(bf16, WS_H), WSP(bf16, WS_WIN), M, 6144, DM, DM, DM, 0, 0}; pg8::StaticOrder S; S.init(M, 6144, F.G, F.bid);
            float* const c32 = WSP(float, WS_ROPE); float* const s32 = c32 + (size_t)M * 32; float* const c64 = s32 + (size_t)M * 32; float* const s64 = c64 + (size_t)M * 64;
            const RmsTab T = rms_table(F, S, WSP(float, WS_SSP) + (size_t)(2 * layer) * M * 32, (LAS float*)(F.lds + TBL_OFF));
            const int nfirst = 2 * ((F.bid & 7) >> 1);
#pragma unroll 1
            for (int part = 0; part < 3; ++part) {
              if (part == 1) { PHASE_BEGIN();
                EpiInProj E{WSP(bf16, WS_P), c32, s32, c64, s64, T, 0, 1.0f, WSP(float, WS_SSP) + (size_t)9 * M * 32, (const int*)GIN(args, 1)};
                pg8::gemm_phase<EpiInProj, true, true>(F.lds + RING_OFF, g, S, E, F.tid);
              } else { PHASE_BEGIN();
                pg8::Gemm g8{(const bf16*)WSP(unsigned char, WS_X8), (const bf16*)WSP(unsigned char, WS_WG8), M, 8192, DM / 2, DM / 2, DM / 2, 0, 0};
                pg8::RangeOrder<pg8::StaticOrder> S8; S8.base.init(M, 8192, F.G, F.bid); S8.lo = part ? nfirst : 0; S8.hi = part ? 1 << 20 : nfirst;
                EpiGate E8{WSP(bf16, WS_GT), T, 1.0f / F8_WSCALE};
                pg8::gemm_phase<EpiGate, true, true, pg8::RangeOrder<pg8::StaticOrder>, true>(F.lds + RING_OFF, g8, S8, E8, F.tid); }
            }
        }
        SEAM(pb + 1);
        if (IN(pb + 2)) { { PHASE_BEGIN();
            bf16* const P = WSP(bf16, WS_P);
            pg8::StaticOrder S; S.init(M, 1024, F.G, F.bid);
            LAS float* tbl = (LAS float*)(F.lds + TBL_OFF);
            { Unit u; const float* css = WSP(float, WS_SSP) + (size_t)9 * M * 32;
              for (int i = 0; i < 4 && S.next(i, u); ++i) if (F.tid < 256) { const float* q = css + (size_t)(u.pm * 256 + F.tid) * 8; const f32x4 a = *(const f32x4*)q, b = *(const f32x4*)(q + 4);
                  const float sm = ((a[0] + a[1]) + (a[2] + a[3])) + ((b[0] + b[1]) + (b[2] + b[3])); tbl[i * 256 + F.tid] = 1.0f / sqrtf(sm * (1.f / 512.f) + EPS); } }
            LDS_WAIT(); __syncthreads();
            pg8::Gemm g{P + PC_CKV, WSP(bf16, WS_WUKV), M, 1024, 512, NP, 512, 0, 0};
            EpiKV E{WSP(bf16, WS_KV), tbl};
            pg8::gemm_phase<EpiKV, true, true>(F.lds + RING_OFF, g, S, E, F.tid); }
#if RET_OPT
            { PHASE_BEGIN(); for (int it = F.bid; it < 512; it += F.G) ret_kv_item(F.lds + RING_OFF, WSP(bf16, WS_P), (float*)(F.ws + WS_MIXF + MX_RKV), it, F.tid); }
#endif
#if LRU_OPT
            { PHASE_BEGIN(); const LruParams LP{GIN(args, 6) + layer * 4 * 512, GIN(args, 7) + layer * 512, GIN(args, 9) + layer * 512, GIN(args, 11) + layer * 512, GIN(args, 12) + layer * 512, WSP(bf16, WS_WLRU)};
              for (int it = F.bid; it < 512; it += F.G) lru_local_item(F.lds + RING_OFF, WSP(bf16, WS_P), LP, (float*)(F.ws + WS_MIXF + MX_LHL), (float*)(F.ws + WS_MIXF + MX_LCA), (float*)(F.ws + WS_MIXF + MX_LTA), (float*)(F.ws + WS_MIXF + MX_LTB), it, F.tid); }
#endif
        }
        SEAM(pb + 2);
        if (IN(pb + 3)) { PHASE_BEGIN();
#if RET_OPT
            for (int it = F.bid; it < 128; it += F.G) ret_scan_item((const float*)(F.ws + WS_MIXF + MX_RKV), (bf16*)(F.ws + WS_MIXF + MX_RSB), it, F.tid);
#endif
#if LRU_OPT
            lru_carry((const float*)(F.ws + WS_MIXF + MX_LTA), (const float*)(F.ws + WS_MIXF + MX_LTB), (float*)(F.ws + WS_MIXF + MX_LCR), F.bid * 512 + F.tid, F.G * 512);
#endif
        }
        SEAM(pb + 3);
        if (IN(pb + 4)) {
#define QPULL(q) (F.tid == 0 ? (void)(F.MISC[16] = __hip_atomic_fetch_add((unsigned*)(F.ctl + CW_Q + (layer * 4 + (q)) * 64), 1u, __ATOMIC_RELAXED, __HIP_MEMORY_SCOPE_AGENT)) : (void)0); \
            __syncthreads(); const int item = (int)F.MISC[16]; __syncthreads(); if (item >= 256) break
#if MLA_OPT
            { PHASE_BEGIN();
            for (;;) { QPULL(1);
                attn_unit<1>(F.lds + RING_OFF, WSP(bf16, WS_P), WSP(bf16, WS_KV), (DIAG && layer == 0) ? WSP(bf16, WS_MIXED) : WSP(bf16, WS_O), (item & 31) >> 2, item & 3, 7 - (item >> 5), F.tid); } }
#endif
#if SB_OPT
            { PHASE_BEGIN();
            for (;;) { QPULL(0);
                attn_unit<0>(F.lds + RING_OFF, WSP(bf16, WS_P), WSP(bf16, WS_KV), (DIAG && layer == 0) ? WSP(bf16, WS_MIXED) : WSP(bf16, WS_O), (item & 31) >> 2, item & 3, 7 - (item >> 5), F.tid); } }
#endif
#if RET_OPT
            { PHASE_BEGIN();
            for (;;) { QPULL(2);
                ret_out_item(F.lds + RING_OFF, WSP(bf16, WS_P), (const bf16*)(F.ws + WS_MIXF + MX_RSB), (DIAG && layer == 0) ? WSP(bf16, WS_MIXED) : WSP(bf16, WS_O), item, F.tid); } }
#endif
#if LRU_OPT
            { PHASE_BEGIN();
            for (;;) { QPULL(3);
                lru_fix(WSP(bf16, WS_P), (const float*)(F.ws + WS_MIXF + MX_LHL), (const float*)(F.ws + WS_MIXF + MX_LCA), (const float*)(F.ws + WS_MIXF + MX_LCR),
                        (DIAG && layer == 0) ? WSP(bf16, WS_MIXED) : WSP(bf16, WS_O), item * 4096 + F.tid, 512, (item + 1) * 4096); } }
#endif
#undef QPULL
        }
        SEAM(pb + 4);
        if (IN(pb + 5)) { PHASE_BEGIN();
            pg8::MergeOrder S; S.base.init(M, DM, F.G, F.bid);
            pg8::Gemm g{WSP(bf16, WS_O), WSP(bf16, WS_WBR), M, DM, 512, DM, 512, (size_t)512 * 2, (size_t)DM * 512 * 2};
            EpiMergeH E{WSP(bf16, WS_GT), WSP(bf16, WS_MIXED)};
            pg8::gemm_phase<EpiMergeH, true, true, pg8::MergeOrder>(F.lds + RING_OFF, g, S, E, F.tid);
        }
        SEAM(pb + 5);
        if (IN(pb + 6)) { PHASE_BEGIN();
            pg8::Gemm g{WSP(bf16, WS_MIXED), WSP(bf16, WS_WOUT), M, DM, DM, DM, DM, 0, 0}; pg8::StaticOrder S; S.init(M, DM, F.G, F.bid);
            EpiResidT<true> E{WSP(bf16, WS_H), WSP(float, WS_SSP) + (size_t)(2 * layer + 1) * M * 32, nullptr};
            if (args.pad) { E.X = WSP(bf16, WS_MIXF); E.SSout = WSP(float, WS_MIXF) + (size_t)20 * MiB; E.X8 = nullptr; }
            pg8::gemm_phase<EpiResidT<true>, true, true>(F.lds + RING_OFF, g, S, E, F.tid);
        }
        SEAM(pb + 6);
        if (IN(pb + 8)) { PHASE_BEGIN();
            pg8::Gemm g{WSP(bf16, WS_H), WSP(bf16, WS_WGU), M, 2 * DFF, DM, DM, DM, 0, 0}; pg8::StaticOrder S; S.init(M, 2 * DFF, F.G, F.bid);
            const RmsTab T = rms_table(F, S, WSP(float, WS_SSP) + (size_t)(2 * layer + 1) * M * 32, (LAS float*)(F.lds + TBL_OFF));
            EpiSwiGLU E{WSP(bf16, WS_P), T};
            pg8::gemm_phase<EpiSwiGLU, true, true>(F.lds + RING_OFF, g, S, E, F.tid);
        }
        SEAM(pb + 8);
        if (IN(pb + 9)) { PHASE_BEGIN();
            pg8::Gemm g{WSP(bf16, WS_P), WSP(bf16, WS_WDN), M, DM, DFF, DFF, DFF, 0, 0}; pg8::StaticOrder S; S.init(M, DM, F.G, F.bid);
            EpiResidT<true> E{WSP(bf16, WS_H), WSP(float, WS_SSP) + (size_t)(2 * layer + 2) * M * 32, (layer + 1 < DEPTH) ? WSP(unsigned char, WS_X8) : nullptr};
            if (args.pad) { E.X = WSP(bf16, WS_MIXF); E.SSout = WSP(float, WS_MIXF) + (size_t)20 * MiB; E.X8 = nullptr; }
            pg8::gemm_phase<EpiResidT<true>, true, true>(F.lds + RING_OFF, g, S, E, F.tid);
        }
        SEAM(pb + 9);
    }
    if (IN(40)) { PHASE_BEGIN(); phase_final(F, WSP(bf16, WS_H), WSP(float, WS_SSP) + (size_t)8 * M * 32, GIN(args, 20), F.out); }
#undef IN
#undef SEAM
}

#if NAIVE_MIX || DIAG
__global__ void __launch_bounds__(256) k_sb_naive(const bf16* __restrict__ P, bf16* __restrict__ O) {
    __shared__ __attribute__((aligned(16))) bf16 Ks[64][128]; __shared__ __attribute__((aligned(16))) bf16 Vs[64][128];
    const int qb = blockIdx.x & 31, h = (blockIdx.x >> 5) & 3, b = blockIdx.x >> 7;
    const int qi = threadIdx.x & 63, dc = threadIdx.x >> 6, t = qb * 64 + qi; const size_t row = (size_t)b * SEQ + t;
    float q[128];
#pragma unroll
    for (int d = 0; d < 128; d += 8) { const u32x4 w = *(const u32x4*)(P + row * NP + PC_SBQ + h * 128 + d);
        q[d] = bflo(w.x); q[d + 1] = bfhi(w.x); q[d + 2] = bflo(w.y); q[d + 3] = bfhi(w.y); q[d + 4] = bflo(w.z); q[d + 5] = bfhi(w.z); q[d + 6] = bflo(w.w); q[d + 7] = bfhi(w.w); }
    float o[32];
#pragma unroll
    for (int j = 0; j < 32; ++j) o[j] = 0.f;
    float R = 0.f;
    for (int kt = qb; kt >= 0; --kt) {
        __syncthreads();
        for (int c = threadIdx.x; c < 64 * 16; c += 256) { const int r = c >> 4, cc = (c & 15) * 8; const size_t kr = (size_t)b * SEQ + kt * 64 + r;
            *(u32x4*)&Ks[r][cc] = *(const u32x4*)(P + kr * NP + PC_SBK + h * 128 + cc); *(u32x4*)&Vs[r][cc] = *(const u32x4*)(P + kr * NP + PC_SBV + h * 128 + cc); }
        __syncthreads();
        for (int s = 63; s >= 0; --s) {
            float z = 0.f;
#pragma unroll
            for (int d = 0; d < 128; d += 8) { const u32x4 w = *(const u32x4*)&Ks[s][d];
                z += q[d] * bflo(w.x) + q[d + 1] * bfhi(w.x) + q[d + 2] * bflo(w.y) + q[d + 3] * bfhi(w.y) + q[d + 4] * bflo(w.z) + q[d + 5] * bfhi(w.z) + q[d + 6] * bflo(w.w) + q[d + 7] * bfhi(w.w); }
            const float sp = fmaxf(z, 0.f) + log2f(1.0f + exp2f(-fabsf(z)));
            if (kt * 64 + s < t) {
                const float w = exp2f(z - sp + R);
#pragma unroll
                for (int j = 0; j < 32; j += 8) { const u32x4 vv = *(const u32x4*)&Vs[s][dc * 32 + j];
                    o[j] += w * bflo(vv.x); o[j + 1] += w * bfhi(vv.x); o[j + 2] += w * bflo(vv.y); o[j + 3] += w * bfhi(vv.y); o[j + 4] += w * bflo(vv.z); o[j + 5] += w * bfhi(vv.z); o[j + 6] += w * bflo(vv.w); o[j + 7] += w * bfhi(vv.w); }
                R -= sp;
            }
        }
    }
#pragma unroll
    for (int j = 0; j < 32; j += 2) *(unsigned*)(O + row * DM + OC_SB + h * 128 + dc * 32 + j) = pk2(o[j], o[j + 1]);
}
__global__ void __launch_bounds__(256) k_mla_naive(const bf16* __restrict__ P, const bf16* __restrict__ KV, bf16* __restrict__ O) {
    __shared__ __attribute__((aligned(16))) bf16 Ks[64][192]; __shared__ __attribute__((aligned(16))) bf16 Vs[64][128];
    const int qb = blockIdx.x & 31, h = (blockIdx.x >> 5) & 3, b = blockIdx.x >> 7;
    const int qi = threadIdx.x & 63, dc = threadIdx.x >> 6, t = qb * 64 + qi; const size_t row = (size_t)b * SEQ + t;
    float q[192];
#pragma unroll
    for (int d = 0; d < 192; d += 8) { const bf16* src = (d < 128) ? (P + row * NP + PC_MQN + h * 128 + d) : (d < 160) ? (P + row * NP + PC_MQP + h * 32 + (d - 128)) : (P + row * NP + PC_MQP + 128 + h * 32 + (d - 160));
        const u32x4 w = *(const u32x4*)src;
        q[d] = bflo(w.x); q[d + 1] = bfhi(w.x); q[d + 2] = bflo(w.y); q[d + 3] = bfhi(w.y); q[d + 4] = bflo(w.z); q[d + 5] = bfhi(w.z); q[d + 6] = bflo(w.w); q[d + 7] = bfhi(w.w); }
    float o[32];
#pragma unroll
    for (int j = 0; j < 32; ++j) o[j] = 0.f;
    float mx = -1e30f, l = 0.f;
    for (int kt = 0; kt <= qb; ++kt) {
        __syncthreads();
        for (int c = threadIdx.x; c < 64 * 24; c += 256) { const int r = c / 24, cc = (c % 24) * 8; const size_t kr = (size_t)b * SEQ + kt * 64 + r;
            const bf16* src = (cc < 128) ? (KV + kr * 1024 + h * 256 + cc) : (cc < 160) ? (P + kr * NP + PC_KPE + (cc - 128)) : (P + kr * NP + PC_KPE + 128 + (cc - 160));
            *(u32x4*)&Ks[r][cc] = *(const u32x4*)src; }
        for (int c = threadIdx.x; c < 64 * 16; c += 256) { const int r = c >> 4, cc = (c & 15) * 8; const size_t kr = (size_t)b * SEQ + kt * 64 + r;
            *(u32x4*)&Vs[r][cc] = *(const u32x4*)(KV + kr * 1024 + h * 256 + 128 + cc); }
        __syncthreads();
        for (int s = 0; s < 64; ++s) {
            float z = 0.f;
#pragma unroll
            for (int d = 0; d < 192; d += 8) { const u32x4 w = *(const u32x4*)&Ks[s][d];
                z += q[d] * bflo(w.x) + q[d + 1] * bfhi(w.x) + q[d + 2] * bflo(w.y) + q[d + 3] * bfhi(w.y) + q[d + 4] * bflo(w.z) + q[d + 5] * bfhi(w.z) + q[d + 6] * bflo(w.w) + q[d + 7] * bfhi(w.w); }
#if DIAG_UNIFORM
            z = 0.f;
#endif
            if (kt * 64 + s <= t) {
                const float mn = fmaxf(mx, z), al = exp2f(mx - mn), p = exp2f(z - mn); mx = mn; l = l * al + p;
#pragma unroll
                for (int j = 0; j < 32; j += 8) { const u32x4 vv = *(const u32x4*)&Vs[s][dc * 32 + j];
                    o[j] = o[j] * al + p * bflo(vv.x); o[j + 1] = o[j + 1] * al + p * bfhi(vv.x); o[j + 2] = o[j + 2] * al + p * bflo(vv.y); o[j + 3] = o[j + 3] * al + p * bfhi(vv.y);
                    o[j + 4] = o[j + 4] * al + p * bflo(vv.z); o[j + 5] = o[j + 5] * al + p * bfhi(vv.z); o[j + 6] = o[j + 6] * al + p * bflo(vv.w); o[j + 7] = o[j + 7] * al + p * bfhi(vv.w); }
            }
        }
    }
    const float il = 1.0f / l;
#pragma unroll
    for (int j = 0; j < 32; j += 2) *(unsigned*)(O + row * DM + OC_MLA + h * 128 + dc * 32 + j) = pk2(o[j] * il, o[j + 1] * il);
}
__global__ void __launch_bounds__(256) k_ret_naive(const bf16* __restrict__ P, bf16* __restrict__ O) {
    __shared__ __attribute__((aligned(16))) bf16 Ks[64][128]; __shared__ __attribute__((aligned(16))) bf16 Vs[64][128]; __shared__ float ssq[64][4];
    const int qb = blockIdx.x & 31, h = (blockIdx.x >> 5) & 3, b = blockIdx.x >> 7;
    const int qi = threadIdx.x & 63, dc = threadIdx.x >> 6, t = qb * 64 + qi; const size_t row = (size_t)b * SEQ + t;
    const int hb = (h >> 1) * 256 + (h & 1) * 64;
    float q[128];
#pragma unroll
    for (int d = 0; d < 128; d += 8) { const u32x4 w = *(const u32x4*)(P + row * NP + PC_RQ + hb + ((d < 64) ? d : 128 + (d - 64)));
        q[d] = bflo(w.x); q[d + 1] = bfhi(w.x); q[d + 2] = bflo(w.y); q[d + 3] = bfhi(w.y); q[d + 4] = bflo(w.z); q[d + 5] = bfhi(w.z); q[d + 6] = bflo(w.w); q[d + 7] = bfhi(w.w); }
    float o[32];
#pragma unroll
    for (int j = 0; j < 32; ++j) o[j] = 0.f;
    const float lg = lg2_gamma(h);
    for (int kt = 0; kt <= qb; ++kt) {
        __syncthreads();
        for (int c = threadIdx.x; c < 64 * 16; c += 256) { const int r = c >> 4, cc = (c & 15) * 8; const size_t kr = (size_t)b * SEQ + kt * 64 + r;
            *(u32x4*)&Ks[r][cc] = *(const u32x4*)(P + kr * NP + PC_RK + hb + ((cc < 64) ? cc : 128 + (cc - 64))); *(u32x4*)&Vs[r][cc] = *(const u32x4*)(P + kr * NP + PC_RV + h * 128 + cc); }
        __syncthreads();
        const float cf = exp2f(lg * 128.0f * (float)((t >> 7) - (kt >> 1)));
        for (int s = 0; s < 64; ++s) {
            float z = 0.f;
#pragma unroll
            for (int d = 0; d < 128; d += 8) { const u32x4 w = *(const u32x4*)&Ks[s][d];
                z += q[d] * bflo(w.x) + q[d + 1] * bfhi(w.x) + q[d + 2] * bflo(w.y) + q[d + 3] * bfhi(w.y) + q[d + 4] * bflo(w.z) + q[d + 5] * bfhi(w.z) + q[d + 6] * bflo(w.w) + q[d + 7] * bfhi(w.w); }
            if (kt * 64 + s <= t) { const float w = z * cf;
#pragma unroll
                for (int j = 0; j < 32; j += 8) { const u32x4 vv = *(const u32x4*)&Vs[s][dc * 32 + j];
                    o[j] += w * bflo(vv.x); o[j + 1] += w * bfhi(vv.x); o[j + 2] += w * bflo(vv.y); o[j + 3] += w * bfhi(vv.y); o[j + 4] += w * bflo(vv.z); o[j + 5] += w * bfhi(vv.z); o[j + 6] += w * bflo(vv.w); o[j + 7] += w * bfhi(vv.w); }
            }
        }
    }
    float ss = 0.f;
#pragma unroll
    for (int j = 0; j < 32; ++j) ss += o[j] * o[j];
    ssq[qi][dc] = ss; __syncthreads();
    const float rs = 1.0f / sqrtf((ssq[qi][0] + ssq[qi][1] + ssq[qi][2] + ssq[qi][3]) * (1.f / 128.f) + EPS);
#pragma unroll
    for (int j = 0; j < 32; j += 2) { const unsigned gw = *(const unsigned*)(P + row * NP + PC_RG + h * 128 + dc * 32 + j);
        *(unsigned*)(O + row * DM + OC_RET + h * 128 + dc * 32 + j) = pk2(o[j] * rs * bflo(gw), o[j + 1] * rs * bfhi(gw)); }
}
__global__ void __launch_bounds__(256) k_lru_conv(const bf16* __restrict__ P, const float* __restrict__ cw, const float* __restrict__ cb, float* __restrict__ XC) {
    const size_t i = (size_t)blockIdx.x * 256 + threadIdx.x; const int c = (int)(i & 511); const size_t row = i >> 9; const int t = (int)(row & (SEQ - 1));
    float acc = cb[c];
#pragma unroll
    for (int tap = 0; tap < 4; ++tap) { const int tt = t - 3 + tap; if (tt >= 0) acc += bf2f(P[(row - 3 + tap) * NP + PC_LX + c]) * cw[tap * 512 + c]; }
    XC[i] = acc;
}
__global__ void __launch_bounds__(256) k_lru_gates(const float* __restrict__ XC, const float* __restrict__ wa, const float* __restrict__ ba, const float* __restrict__ wx, const float* __restrict__ bx,
                                                   const float* __restrict__ lam, float* __restrict__ Aout, float* __restrict__ Bout) {
    const size_t i = (size_t)blockIdx.x * 256 + threadIdx.x; const int c = (int)(i & 511); const size_t row = i >> 9; const int blk = c >> 7, cc = c & 127;
    const float* xr = XC + row * 512 + blk * 128; const float* wap = wa + (size_t)blk * 128 * 128 + cc; const float* wxp = wx + (size_t)blk * 128 * 128 + cc;
    float ra = ba[c], ri = bx[c];
    for (int k = 0; k < 128; ++k) { const float xv = xr[k]; ra += xv * wap[k * 128]; ri += xv * wxp[k * 128]; }
    const float r = 1.0f / (1.0f + expf(-ra)), ig = 1.0f / (1.0f + expf(-ri));
    const float lm = lam[c]; const float sp = fmaxf(-lm, 0.f) + log1pf(expf(-fabsf(lm)));
    const float log_a = -8.0f * r * sp; const float a = expf(log_a); const float mult = sqrtf(-expm1f(2.0f * log_a));
    Aout[i] = a; Bout[i] = mult * (ig * XC[i]);
}
__global__ void __launch_bounds__(64) k_lru_scan(const float* __restrict__ Ain, const float* __restrict__ Bin, const bf16* __restrict__ P, bf16* __restrict__ O) {
    const int i = blockIdx.x * 64 + threadIdx.x; const int c = i & 511, b = i >> 9;
    float hst = 0.f;
    for (int t = 0; t < SEQ; ++t) { const size_t row = (size_t)b * SEQ + t; hst = Ain[row * 512 + c] * hst + Bin[row * 512 + c];
        O[row * DM + OC_LRU + c] = (bf16)f2bf(hst * bf2f(P[row * NP + PC_LY + c])); }
}


__global__ void k_diag(const bf16* __restrict__ A, const bf16* __restrict__ B, int col0, float tol, unsigned* res) {
    const int row = blockIdx.x; const int c = threadIdx.x;
    const float a = bf2f(A[(size_t)row * DM + col0 + c]), b = bf2f(B[(size_t)row * DM + col0 + c]);
    const float d = fabsf(a - b); const bool bad = !(d <= tol * (1.0f + fabsf(a)));
    __shared__ unsigned nb;
    if (c == 0) nb = 0; __syncthreads();
    if (bad) { atomicAdd(&nb, 1u); atomicMax(res + 2, __builtin_bit_cast(unsigned, d)); }
    __syncthreads();
    if (c == 0 && nb) { atomicAdd(res + 0, 1u); atomicMin(res + 1, (unsigned)row); atomicAdd(res + 3, nb); const int t = row & (SEQ - 1);
        atomicAdd(res + 8 + (t >> 5), 1u);
        atomicAdd(res + 300 + (row >> 11), 1u); atomicAdd(res + 310 + (t >> 8), 1u); }
    if (bad) { const int hh = c >> 7, d_ = c & 127; atomicAdd(res + 128 + d_, 1u); atomicAdd(res + 256 + hh, 1u); }
}
__global__ void k_diag_init(unsigned* res) { if (threadIdx.x < 512) res[threadIdx.x] = (threadIdx.x == 1) ? 0xffffffffu : 0u; }
__device__ float diag_encode(unsigned v) {
    float x = (float)(v % 90u + 10u) * 100.0f; for (unsigned e = 0; e < v / 90u; ++e) x *= 10.0f; return x;
}
__global__ void k_diag_row0(const bf16* __restrict__ O2, const bf16* __restrict__ KV, unsigned* res) {
    if (threadIdx.x == 0) { unsigned best = 0, bestn = 0, n0 = 0;
        for (int k = 0; k < 256; ++k) { unsigned n = 0; for (int d = 0; d < 128; ++d) if (O2[OC_MLA + d] == KV[(size_t)k * 1024 + 128 + d]) ++n; if (k == 0) n0 = n; if (n > bestn) { bestn = n; best = k; } }
        res[400] = best; res[401] = bestn; res[402] = n0;
        for (int g = 0; g < 16; ++g) { unsigned bk = 999; for (int k = 0; k < 256 && bk == 999; ++k) { bool ok = true; for (int d = 0; d < 8; ++d) if (O2[OC_MLA + g * 8 + d] != KV[(size_t)k * 1024 + 128 + g * 8 + d]) ok = false; if (ok) bk = k; } res[410 + g] = bk; } }
}
__global__ void k_diag_encode(float* out, const unsigned* res, int mode) {
    unsigned v = 0;
    if (mode >= 120 && mode < 130) { out[0] += diag_encode(res[440 + mode - 120] > 2600u ? 2600u : res[440 + mode - 120]); return; }
    if (mode >= 100 && mode < 103) { out[0] += diag_encode(res[400 + mode - 100]); return; }
    if (mode >= 110 && mode < 120) { out[0] += diag_encode(res[410 + mode - 110]); return; }
    if (mode == 0) v = res[0] >> 6;
    else if (mode == 1) v = res[1] == 0xffffffffu ? 2699u : (res[1] & (SEQ - 1));
    else if (mode == 2) v = res[1] == 0xffffffffu ? 2699u : (res[1] >> 11);
    else if (mode == 3) { const float d = __builtin_bit_cast(float, res[2]); v = (unsigned)fminf(d * 100.0f, 2000.0f); }
    else if (mode == 4) { unsigned m = 0; for (int i = 0; i < 64; ++i) if (res[8 + i]) m |= 0; unsigned first = 99, last = 0, cnt = 0; for (int i = 0; i < 64; ++i) if (res[8 + i]) { if (first == 99) first = i; last = i; ++cnt; } v = cnt; }
    else if (mode == 5) { unsigned cnt = 0; for (int i = 0; i < 128; ++i) if (res[128 + i]) ++cnt; v = cnt; }
    else if (mode == 6) { unsigned m = 0; for (int i = 0; i < 4; ++i) if (res[256 + i]) m |= 1u << i; v = m; }
    else if (mode == 7) { unsigned first = 999; for (int i = 0; i < 128; ++i) if (res[128 + i]) { first = i; break; } v = first; }
    else if (mode == 8) { unsigned m = 0; for (int i = 0; i < 8; ++i) { unsigned any = 0; for (int j = 0; j < 8; ++j) any |= res[8 + ((i + 8 * j) & 63)]; if (any) m |= 1u << i; } v = m; }
    else if (mode == 9) { unsigned m = 0; for (int i = 0; i < 8; ++i) if (res[300 + i]) m |= 1u << i; v = m; }
    else if (mode == 10) { unsigned m = 0; for (int i = 0; i < 8; ++i) if (res[310 + i]) m |= 1u << i; v = m; }
    else if (mode == 11) { unsigned mx = 0, arg = 0; for (int i = 0; i < 8; ++i) if (res[310 + i] > mx) { mx = res[310 + i]; arg = i; } v = arg * 300 + (mx >> 3); }
    else if (mode >= 12 && mode < 20) v = res[310 + (mode - 12)];
    else if (mode >= 20 && mode < 84) v = res[8 + (mode - 20)];
    out[0] += diag_encode(v);
}

#endif

extern "C" void kernel_launch(void* const* d_in, const int* in_sizes, int n_in, void* d_out, int out_size, void* d_ws, size_t ws_size, hipStream_t stream) {
    static int grid = 0;
    if (grid == 0) {
        if (n_in != 21 || out_size != M * DM || ws_size < WS_END) { fprintf(stderr, "kernel_launch: unexpected shapes (n_in %d, out %d, ws %zu < %zu)\n", n_in, out_size, ws_size, (size_t)WS_END); grid = -1; return; }
        int dev = 0, cus = 0, per_cu = 0;
        if (hipGetDevice(&dev) != hipSuccess || hipDeviceGetAttribute(&cus, hipDeviceAttributeMultiprocessorCount, dev) != hipSuccess) { grid = -1; return; }
        if (hipFuncSetAttribute((const void*)mega_fwd, hipFuncAttributeMaxDynamicSharedMemorySize, LDS_BYTES) != hipSuccess) { fprintf(stderr, "kernel_launch: hipFuncSetAttribute failed\n"); grid = -1; return; }
        if (hipOccupancyMaxActiveBlocksPerMultiprocessor(&per_cu, (const void*)mega_fwd, NWAVES * 64, LDS_BYTES) != hipSuccess || per_cu < 1) fprintf(stderr, "kernel_launch: occupancy query reports %d\n", per_cu);
        (void)hipGetLastError();
        grid = cus;
    }
    if (grid < 0) return;
    (void)hipMemsetAsync((char*)d_ws + WS_CTL, 0, CTL_ZERO_BYTES, stream);
    Args a{};
    for (int i = 0; i < 21; ++i) a.in[i] = (const float*)d_in[i];
    a.out = (float*)d_out; a.ws = (unsigned char*)d_ws;
    int li = 0;
    auto persist = [&](int lo, int hi) { a.ph_lo = lo; a.ph_hi = hi; a.li = li++; hipLaunchKernelGGL(mega_fwd, dim3(grid), dim3(NWAVES * 64), LDS_BYTES, stream, a); };
#if NAIVE_MIX
    unsigned char* ws = (unsigned char*)d_ws;
    const bf16* P = (const bf16*)(ws + WS_P); const bf16* KV = (const bf16*)(ws + WS_KV); bf16* O = (bf16*)(ws + WS_O);
    float* XC = (float*)(ws + WS_MIXF); float* LA = XC + (size_t)M * 512; float* LB = LA + (size_t)M * 512;
    int lo = 0;
#if DIAG
    hipLaunchKernelGGL(k_diag_init, dim3(1), dim3(512), 0, stream, (unsigned*)(ws + WS_CTL + 256 * 1024));
#endif
    for (int L = 0; L < DEPTH; ++L) {
        persist(lo, L * 10 + 5);
#if !SB_OPT || DIAG
        hipLaunchKernelGGL(k_sb_naive, dim3(BATCH * 4 * 32), dim3(256), 0, stream, P, O);
#endif
#if !MLA_OPT || DIAG
        hipLaunchKernelGGL(k_mla_naive, dim3(BATCH * 4 * 32), dim3(256), 0, stream, P, KV, O);
#endif
#if !RET_OPT || DIAG
        hipLaunchKernelGGL(k_ret_naive, dim3(BATCH * 4 * 32), dim3(256), 0, stream, P, O);
#endif
#if !LRU_OPT || DIAG
        hipLaunchKernelGGL(k_lru_conv, dim3(M * 512 / 256), dim3(256), 0, stream, P, (const float*)d_in[6] + L * 4 * 512, (const float*)d_in[7] + L * 512, XC);
        hipLaunchKernelGGL(k_lru_gates, dim3(M * 512 / 256), dim3(256), 0, stream, (const float*)XC, (const float*)d_in[8] + (size_t)L * 4 * 128 * 128, (const float*)d_in[9] + L * 512,
                           (const float*)d_in[10] + (size_t)L * 4 * 128 * 128, (const float*)d_in[11] + L * 512, (const float*)d_in[12] + L * 512, LA, LB);
        hipLaunchKernelGGL(k_lru_scan, dim3(BATCH * 512 / 64), dim3(64), 0, stream, (const float*)LA, (const float*)LB, P, O);
#endif
#if DIAG
        if (L == 0) { unsigned* res = (unsigned*)(ws + WS_CTL + 256 * 1024);
            hipLaunchKernelGGL(k_diag, dim3(M), dim3(512), 0, stream, (const bf16*)O, (const bf16*)(ws + WS_MIXED), (int)DIAG_COL, 0.03f, res);
            hipLaunchKernelGGL(k_diag_row0, dim3(1), dim3(64), 0, stream, (const bf16*)(ws + WS_MIXED), KV, res); }
#endif
        lo = L * 10 + 5;
    }
    persist(lo, 41);
#if DIAG
    hipLaunchKernelGGL(k_diag_encode, dim3(1), dim3(1), 0, stream, (float*)d_out, (const unsigned*)(ws + WS_CTL + 256 * 1024), (int)DIAG_MODE);
#endif
#elif REPEAT_PHASE >= 0
    { int lo = 0; const int k = REPEAT_PHASE;
      for (int L = 0; L < DEPTH; ++L) { persist(lo, L * 10 + k + 1);
          if (k == 4) (void)hipMemsetAsync((char*)d_ws + WS_CTL + CW_Q * 4, 0, 16 * 64 * 4, stream);
          a.pad = (k == 6 || k == 9) ? 1 : 0; persist(L * 10 + k, L * 10 + k + 1); a.pad = 0; lo = L * 10 + k + 1; }
      persist(lo, 41); }
#else
    persist(0, 41);
#endif
}
```
